# Optimizing an MI355X kernel written in HIP

```python
import jax, jax.numpy as jnp
from jax import lax
import numpy as np

D_MODEL = 1024
BATCH = 8
SEQ = 2048
DEPTH = 1

HG_HEADS = 4
HG_KEY_DIM = 128
HG_VAL_DIM = 128
HG_KEY_WIDTH = HG_HEADS * HG_KEY_DIM
HG_VAL_WIDTH = HG_HEADS * HG_VAL_DIM
HG_CHUNK = 64
ATT_GROUPS = ((128, 1), (512, 4), (2048, 16))
N_ATT_GROUPS = 3
ATT_HEADS = 8
ATT_HEAD_DIM = 64
ATT_WIDTH = ATT_HEADS * ATT_HEAD_DIM
ATT_BLOCK = 128
ALIBI_MAX = 8.0
D_FF = 2816
IN_SIZES = (HG_KEY_WIDTH, HG_KEY_WIDTH, HG_VAL_WIDTH, HG_VAL_WIDTH, N_ATT_GROUPS * 3 * ATT_WIDTH, D_MODEL, D_MODEL)
IN_COLS = sum(IN_SIZES)
EPS = 1e-6
NEG_INF = -1e30

kernel_name = "hybrid_hgrn2_dilated_alibi_macaron"


def _rmsnorm(x, gain):
    xf = x.astype(jnp.float32)
    xf = xf * lax.rsqrt(jnp.mean(xf * xf, axis=-1, keepdims=True) + EPS)
    return xf.astype(x.dtype) * gain


def _swiglu(x, w_gate_up, w_down):
    a, b = jnp.split(x @ w_gate_up, 2, axis=-1)
    return (jax.nn.silu(a) * b) @ w_down


def _hgrn2(q, f_pre, i, og, lower_bound, out_gain):
    B, S, _ = q.shape
    dt = q.dtype
    H, K, V, C = HG_HEADS, HG_KEY_DIM, HG_VAL_DIM, HG_CHUNK
    lb = lower_bound.reshape(H, K)
    f = lb + (1.0 - lb) * jax.nn.sigmoid(f_pre.astype(jnp.float32).reshape(B, S, H, K))
    log_f = jnp.log(f)
    k = 1.0 - f
    qf = q.astype(jnp.float32).reshape(B, S, H, K)
    v = i.astype(jnp.float32).reshape(B, S, H, V)
    Sp = -(-S // C) * C
    pad = Sp - S

    def to_chunks(a):
        a = jnp.pad(a, ((0, 0), (0, pad), (0, 0), (0, 0)))
        return a.reshape(B, Sp // C, C, H, a.shape[-1]).transpose(1, 0, 3, 2, 4)

    qc, kc, vc, gc = to_chunks(qf), to_chunks(k), to_chunks(v), to_chunks(log_f)
    Gc = jnp.cumsum(gc, axis=3)
    causal = jnp.tril(jnp.ones((C, C), dtype=bool))[:, :, None]

    def step(state, inp):
        q_, k_, v_, G = inp
        diff = G[:, :, :, None, :] - G[:, :, None, :, :]
        decay = jnp.where(causal, jnp.exp(jnp.where(causal, diff, 0.0)), 0.0)
        scores = jnp.einsum('bhtk,bhsk,bhtsk->bhts', q_, k_, decay)
        o = (jnp.einsum('bhts,bhsv->bhtv', scores, v_)
             + jnp.einsum('bhtk,bhkv->bhtv', q_ * jnp.exp(G), state))
        G_last = G[:, :, -1:, :]
        new_state = (jnp.exp(G_last[:, :, 0, :])[..., None] * state
                     + jnp.einsum('bhsk,bhsv->bhkv', k_ * jnp.exp(G_last - G), v_))
        return new_state, o

    state0 = jnp.zeros((B, H, K, V), jnp.float32)
    _, oc = lax.scan(step, state0, (qc, kc, vc, Gc))
    o = oc.transpose(1, 0, 3, 2, 4).reshape(B, Sp, H, V)[:, :S]
    o = o * lax.rsqrt(jnp.mean(o * o, axis=-1, keepdims=True) + EPS)
    o = o.reshape(B, S, H * V).astype(dt) * out_gain
    return o * jax.nn.silu(og)


def _dilated_group(q, k, v, window, dilation, slopes):
    B, S, H, E = q.shape
    BLK = ATT_BLOCK
    span = window // dilation
    unit = dilation * BLK
    Sp = -(-S // unit) * unit
    L = Sp // dilation
    nb = L // BLK

    def to_blocks(a):
        a = jnp.pad(a, ((0, 0), (0, Sp - S), (0, 0), (0, 0)))
        return a.reshape(B, nb, BLK, dilation, H, E)

    def band(a):
        prev = jnp.pad(a, ((0, 0), (1, 0), (0, 0), (0, 0), (0, 0), (0, 0)))[:, :-1]
        return jnp.concatenate([prev, a], axis=2)

    qb = to_blocks(q)
    kband, vband = band(to_blocks(k)), band(to_blocks(v))
    scores = jnp.einsum('bnqrhe,bnkrhe->bnrhqk', qb, kband).astype(jnp.float32) * (E ** -0.5)
    qi = jnp.arange(BLK)[:, None]
    kj = jnp.arange(2 * BLK)[None, :]
    delta = qi + BLK - kj
    blk_idx = jnp.arange(nb)[:, None, None]
    valid = (delta >= 0) & (delta <= span) & ((blk_idx > 0) | (kj >= BLK))
    bias = -slopes[:, None, None] * (dilation * delta).astype(jnp.float32)
    scores = scores + bias[None, None, None]
    scores = jnp.where(valid[None, :, None, None], scores, NEG_INF)
    lse = jax.nn.logsumexp(scores, axis=-1)
    p = jnp.exp(scores - lse[..., None]).astype(v.dtype)
    o = jnp.einsum('bnrhqk,bnkrhe->bnqrhe', p, vband).reshape(B, Sp, H, E)[:, :S]
    lse = lse.transpose(0, 1, 4, 2, 3).reshape(B, Sp, H)[:, :S]
    return o, lse


def _mixer(u, w_in, lower_bound, hg_out_norm, w_branch_hg, w_branch_att, w_out):
    B, S, _ = u.shape
    dt = u.dtype
    points = [int(p) for p in np.cumsum(IN_SIZES)[:-1]]
    hg_q, hg_f, hg_i, hg_og, att, gate_hg, gate_att = jnp.split(u @ w_in, points, axis=-1)
    y_hg = _hgrn2(hg_q, hg_f, hg_i, hg_og, lower_bound, hg_out_norm)
    n_heads = N_ATT_GROUPS * ATT_HEADS
    slopes = jnp.exp2(-ALIBI_MAX * jnp.arange(1, n_heads + 1, dtype=jnp.float32) / n_heads)
    qkv = att.reshape(B, S, N_ATT_GROUPS, 3, ATT_HEADS, ATT_HEAD_DIM)
    outs, lses = [], []
    for g, (window, dilation) in enumerate(ATT_GROUPS):
        o, lse = _dilated_group(qkv[:, :, g, 0], qkv[:, :, g, 1], qkv[:, :, g, 2], window, dilation,
                                slopes[g * ATT_HEADS:(g + 1) * ATT_HEADS])
        outs.append(o)
        lses.append(lse)
    wts = jax.nn.softmax(jnp.stack(lses), axis=0).astype(dt)
    y_att = jnp.einsum('gbshe,gbsh->bshe', jnp.stack(outs), wts).reshape(B, S, ATT_WIDTH)
    merged = (jax.nn.sigmoid(gate_hg) * (y_hg @ w_branch_hg)
              + jax.nn.sigmoid(gate_att) * (y_att @ w_branch_att))
    return merged @ w_out


def setup_inputs(seed: int = 0) -> dict:
    key = jax.random.key(seed)
    ks = jax.random.split(key, 16)

    def nrm(k, shape, scale):
        return jax.random.normal(k, shape, jnp.float32) * scale

    return {
        "x": nrm(ks[0], (BATCH, SEQ, D_MODEL), 1.0),
        "ffn1_norm": 1.0 + nrm(ks[1], (DEPTH, D_MODEL), 0.02),
        "ffn1_w_gate_up": nrm(ks[2], (DEPTH, D_MODEL, 2 * D_FF), D_MODEL ** -0.5),
        "ffn1_w_down": nrm(ks[3], (DEPTH, D_FF, D_MODEL), D_FF ** -0.5),
        "mix_norm": 1.0 + nrm(ks[4], (DEPTH, D_MODEL), 0.02),
        "w_in": nrm(ks[5], (DEPTH, D_MODEL, IN_COLS), D_MODEL ** -0.5),
        "hg_lower_bounds": nrm(ks[6], (DEPTH + 1, HG_KEY_WIDTH), 0.1),
        "hg_out_norm": 1.0 + nrm(ks[7], (DEPTH, HG_VAL_WIDTH), 0.02),
        "w_branch_hg": nrm(ks[8], (DEPTH, HG_VAL_WIDTH, D_MODEL), HG_VAL_WIDTH ** -0.5),
        "w_branch_att": nrm(ks[9], (DEPTH, ATT_WIDTH, D_MODEL), ATT_WIDTH ** -0.5),
        "w_out": nrm(ks[10], (DEPTH, D_MODEL, D_MODEL), D_MODEL ** -0.5),
        "ffn2_norm": 1.0 + nrm(ks[11], (DEPTH, D_MODEL), 0.02),
        "ffn2_w_gate_up": nrm(ks[12], (DEPTH, D_MODEL, 2 * D_FF), D_MODEL ** -0.5),
        "ffn2_w_down": nrm(ks[13], (DEPTH, D_FF, D_MODEL), D_FF ** -0.5),
        "final_norm": 1.0 + nrm(ks[14], (D_MODEL,), 0.02),
    }


def reference(x, ffn1_norm, ffn1_w_gate_up, ffn1_w_down, mix_norm, w_in, hg_lower_bounds, hg_out_norm,
              w_branch_hg, w_branch_att, w_out, ffn2_norm, ffn2_w_gate_up, ffn2_w_down, final_norm):
    lower_bounds = jnp.cumsum(jax.nn.softmax(hg_lower_bounds.astype(jnp.float32), axis=0), axis=0)
    h = x
    for l in range(DEPTH):
        h = h + 0.5 * _swiglu(_rmsnorm(h, ffn1_norm[l]), ffn1_w_gate_up[l], ffn1_w_down[l])
        h = h + _mixer(_rmsnorm(h, mix_norm[l]), w_in[l], lower_bounds[l], hg_out_norm[l],
                       w_branch_hg[l], w_branch_att[l], w_out[l])
        h = h + 0.5 * _swiglu(_rmsnorm(h, ffn2_norm[l]), ffn2_w_gate_up[l], ffn2_w_down[l])
    return _rmsnorm(h, final_norm)
```

```cpp
#include <hip/hip_runtime.h>
#include <cstdio>
#include <cstdint>
namespace pg8 {
#define PG8_LAS __attribute__((address_space(3)))
typedef unsigned short bf16_t;
typedef short bf16x8 __attribute__((ext_vector_type(8)));
typedef float f32x4 __attribute__((ext_vector_type(4)));
typedef unsigned u32x4 __attribute__((ext_vector_type(4)));
constexpr int BM = 256, BK = 64, HALF = 128, HTB = HALF * BK * 2  , STAGE_BYTES = 8 * HTB, NXCD = 8, WGM = 8;

__host__ __device__ __forceinline__ int lds_byte(int r, int c) { const int st = (r >> 4) * 2 + (c >> 5), rr = r & 15, cc = c & 31, ob = rr * 64 + cc * 2; return st * 1024 + (ob ^ (((ob >> 9) & 1) << 5)); }
__host__ __device__ __forceinline__ void stage_rc(int b, int& R, int& C) { const int st = b / 1024, sb = b % 1024, swz = sb ^ (((sb >> 9) & 1) << 5); R = (st >> 1) * 16 + swz / 64; C = (st & 1) * 32 + (swz % 64) / 2; }
__host__ __device__ __forceinline__ int perm32(int rho) { const int n = rho >> 4, i = rho & 15; return 8 * (i >> 2) + 4 * n + (i & 3); }

struct Unit { int pm, pn, z; };
struct Gemm { const bf16_t* A; const bf16_t* Bt; const bf16_t* A1; const bf16_t* Bt1; int K; };

struct StaticOrder {
    int nM, nN, nwg, G, c;
    __host__ __device__ void init(int M, int N, int G_, int c_) { nM = M / BM; nN = N / BM; nwg = nM * nN; G = G_; c = c_; }
    __host__ __device__ bool next(int i, Unit& u) const {
        const long L = (long)i * G + c; if (L >= nwg) return false;
        int wgid = (int)L; { const int q = nwg / NXCD, r = nwg % NXCD, xcd = wgid % NXCD, off = wgid / NXCD; wgid = (xcd < r ? xcd * (q + 1) : r * (q + 1) + (xcd - r) * q) + off; }
        const int nig = WGM * nN, gid = wgid / nig, fm = gid * WGM, gsz = (nM - fm) < WGM ? (nM - fm) : WGM;
        u.pm = fm + ((wgid % nig) % gsz); u.pn = (wgid % nig) / gsz; u.z = 0; return true;
    }
    __device__ __forceinline__ void a_ready(const Unit&) const {}
    __device__ __forceinline__ void done(const Unit&) const {}
};


__device__ __forceinline__ unsigned cvt_pk_bf16(float lo, float hi) { unsigned r; asm volatile("v_cvt_pk_bf16_f32 %0, %1, %2" : "=v"(r) : "v"(lo), "v"(hi)); return r; }
typedef float f32x2 __attribute__((ext_vector_type(2)));
__device__ __forceinline__ float fast_sigmoid(float x) { return __builtin_amdgcn_rcpf(1.0f + __builtin_amdgcn_exp2f(-1.4426950408889634f * x)); }
__device__ __forceinline__ float bf_lo(unsigned w) { return __uint_as_float(w << 16); }
__device__ __forceinline__ float bf_hi(unsigned w) { return __uint_as_float(w & 0xffff0000u); }
__device__ __forceinline__ float row_rstd(const float* ss, int row) { return rsqrtf(ss[row] * (1.0f / 1024.0f) + 1e-6f); }
__device__ __forceinline__ u32x4 pack8(const float (&h)[8]) { u32x4 w; w.x = cvt_pk_bf16(h[0], h[1]); w.y = cvt_pk_bf16(h[2], h[3]); w.z = cvt_pk_bf16(h[4], h[5]); w.w = cvt_pk_bf16(h[6], h[7]); return w; }

struct EpiSwiGLU {
    static constexpr bool PERM = true, AFTER_DRAIN = false;
    bf16_t* O; const float* ss; int ldo;
    __device__ __forceinline__ void operator()(const f32x4 (&acc)[2][2][4][2], const Unit& u, int wr, int wc, int fr, int fq) const {
        const int row0 = u.pm * BM + wr * 64 + fr, col0 = u.pn * 128 + wc * 32 + 8 * fq;
#pragma unroll
        for (int ai = 0; ai < 2; ++ai)
#pragma unroll
            for (int m = 0; m < 4; ++m) {
                const int row = row0 + ai * HALF + m * 16; const float rs = row_rstd(ss, row);
                float h[8];
#pragma unroll
                for (int n = 0; n < 2; ++n)
#pragma unroll
                    for (int i = 0; i < 4; ++i) { const float g = acc[ai][0][m][n][i] * rs, up = acc[ai][1][m][n][i] * rs; h[4 * n + i] = g * fast_sigmoid(g) * up; }
                *(u32x4*)(O + (size_t)row * ldo + col0) = pack8(h);
            }
    }
};
struct EpiResid {
    static constexpr bool PERM = true, AFTER_DRAIN = false;
    const float* base; float* outf; bf16_t* hb; float* ss_out; float scale;
    __device__ __forceinline__ void operator()(const f32x4 (&acc)[2][2][4][2], const Unit& u, int wr, int wc, int fr, int fq) const {
        const int row0 = u.pm * BM + wr * 64 + fr;
#pragma unroll
        for (int ai = 0; ai < 2; ++ai)
#pragma unroll
            for (int m = 0; m < 4; ++m) {
                const int row = row0 + ai * HALF + m * 16; float ssq = 0.f;
#pragma unroll
                for (int bj = 0; bj < 2; ++bj) {
                    const size_t off = (size_t)row * 1024 + u.pn * BM + bj * HALF + wc * 32 + 8 * fq;
                    const f32x4 b0 = *(const f32x4*)(base + off), b1 = *(const f32x4*)(base + off + 4);
                    const f32x4 v0 = b0 + acc[ai][bj][m][0] * scale, v1 = b1 + acc[ai][bj][m][1] * scale;
                    *(f32x4*)(outf + off) = v0; *(f32x4*)(outf + off + 4) = v1;
                    const float h[8] = {v0[0], v0[1], v0[2], v0[3], v1[0], v1[1], v1[2], v1[3]};
                    *(u32x4*)(hb + off) = pack8(h);
#pragma unroll
                    for (int i = 0; i < 8; ++i) ssq += h[i] * h[i];
                }
                ssq += __shfl_xor(ssq, 16); ssq += __shfl_xor(ssq, 32);
                if (fq == 0) atomicAdd(ss_out + row, ssq);
            }
    }
};
struct EpiProj {
    static constexpr bool PERM = true, AFTER_DRAIN = false;
    bf16_t* o1; int ld1; bf16_t* o2; int ld2; int split_pn; const float* ss;
    __device__ __forceinline__ void operator()(const f32x4 (&acc)[2][2][4][2], const Unit& u, int wr, int wc, int fr, int fq) const {
        const int row0 = u.pm * BM + wr * 64 + fr; const bool second = u.pn >= split_pn;
        bf16_t* dst = second ? o2 : o1; const int ld = second ? ld2 : ld1; const int colt = (second ? u.pn - split_pn : u.pn) * BM + wc * 32 + 8 * fq;
#pragma unroll
        for (int ai = 0; ai < 2; ++ai)
#pragma unroll
            for (int m = 0; m < 4; ++m) {
                const int row = row0 + ai * HALF + m * 16; const float rs = row_rstd(ss, row);
#pragma unroll
                for (int bj = 0; bj < 2; ++bj) {
                    float h[8];
#pragma unroll
                    for (int n = 0; n < 2; ++n)
#pragma unroll
                        for (int i = 0; i < 4; ++i) { const float v = acc[ai][bj][m][n][i] * rs; h[4 * n + i] = second ? fast_sigmoid(v) : v; }
                    *(u32x4*)(dst + (size_t)row * ld + colt + bj * HALF) = pack8(h);
                }
            }
    }
};
struct EpiMerge {
    static constexpr bool PERM = true, AFTER_DRAIN = false;
    const bf16_t* gates; bf16_t* tmp; bf16_t* merged;
    __device__ __forceinline__ void operator()(const f32x4 (&acc)[2][2][4][2], const Unit& u, int wr, int wc, int fr, int fq) const {
        const int row0 = u.pm * BM + wr * 64 + fr;
#pragma unroll
        for (int ai = 0; ai < 2; ++ai)
#pragma unroll
            for (int m = 0; m < 4; ++m) {
                const int row = row0 + ai * HALF + m * 16;
#pragma unroll
                for (int bj = 0; bj < 2; ++bj) {
                    const int col = u.pn * BM + bj * HALF + wc * 32 + 8 * fq;
                    const u32x4 gw = *(const u32x4*)(gates + (size_t)row * 2048 + u.z * 1024 + col);
                    const float gt[8] = {bf_lo(gw.x), bf_hi(gw.x), bf_lo(gw.y), bf_hi(gw.y), bf_lo(gw.z), bf_hi(gw.z), bf_lo(gw.w), bf_hi(gw.w)};
                    float h[8];
#pragma unroll
                    for (int n = 0; n < 2; ++n)
#pragma unroll
                        for (int i = 0; i < 4; ++i) h[4 * n + i] = acc[ai][bj][m][n][i] * gt[4 * n + i];
                    if (u.z) {
                        const u32x4 tw = *(const u32x4*)(tmp + (size_t)row * 1024 + col);
                        h[0] += bf_lo(tw.x); h[1] += bf_hi(tw.x); h[2] += bf_lo(tw.y); h[3] += bf_hi(tw.y); h[4] += bf_lo(tw.z); h[5] += bf_hi(tw.z); h[6] += bf_lo(tw.w); h[7] += bf_hi(tw.w);
                        *(u32x4*)(merged + (size_t)row * 1024 + col) = pack8(h);
                    } else *(u32x4*)(tmp + (size_t)row * 1024 + col) = pack8(h);
                }
            }
    }
};
struct MergeOrder : StaticOrder {
    __host__ __device__ bool next(int i, Unit& u) const { if (!StaticOrder::next(i >> 1, u)) return false; u.z = i & 1; return true; }
};

template <class Epi, class Sched, bool ALIGN_EPI = false, bool SP2 = false>
__device__ __forceinline__ void gemm_phase(PG8_LAS unsigned char* lds, const Gemm g, const Sched& S, const Epi& E) {
    const int tid = threadIdx.x, wid = __builtin_amdgcn_readfirstlane(tid >> 6), lane = tid & 63, wr = wid >> 2, wc = wid & 3, fr = lane & 15, fq = lane >> 4;
    const int K = g.K, nt = K / BK;
    unsigned voffA[2], voffB[2];
#pragma unroll
    for (int i = 0; i < 2; ++i) { int R, C; stage_rc(tid * 16 + i * 8192, R, C); const int Rb = Epi::PERM ? ((R & ~31) + perm32(R & 31)) : R;
        voffA[i] = (unsigned)(R * K + C) * 2u; voffB[i] = (unsigned)(Rb * K + C) * 2u; }
    const size_t kstep = (size_t)(BK * 2);
    const size_t hstep = (size_t)HALF * K * 2;
    const size_t tstep = 2 * hstep;
    const unsigned ldsw = (unsigned)wid * 1024u;
    const int aoff = lds_byte(wr * 64 + fr, fq * 8), boff = lds_byte(wc * 32 + fr, fq * 8);
#define PG8_SA(b, h) (((b) * 2 + (h)) * HTB)
#define PG8_SB(b, h) ((4 + (b) * 2 + (h)) * HTB)
#define PG8_STAGE(bufoff, gbase, voff) do { _Pragma("unroll") for (int _i = 0; _i < 2; ++_i) \
        __builtin_amdgcn_global_load_lds((const unsigned*)((const char*)(gbase) + (voff)[_i]), (PG8_LAS unsigned*)(lds + (bufoff) + ldsw + _i * 8192), 16, 0, 0); } while (0)
#define PG8_LDA(dst, b, h) do { _Pragma("unroll") for (int m = 0; m < 4; ++m) _Pragma("unroll") for (int k = 0; k < 2; ++k) dst[m][k] = *(const PG8_LAS bf16x8*)(lds + PG8_SA(b, h) + aoff + m * 2048 + k * 1024); } while (0)
#define PG8_LDB(dst, b, h) do { _Pragma("unroll") for (int n = 0; n < 2; ++n) _Pragma("unroll") for (int k = 0; k < 2; ++k) dst[n][k] = *(const PG8_LAS bf16x8*)(lds + PG8_SB(b, h) + boff + n * 2048 + k * 1024); } while (0)
#define PG8_MMA(ai, bj, At, Bt) do { __builtin_amdgcn_s_setprio(1); _Pragma("unroll") for (int m = 0; m < 4; ++m) _Pragma("unroll") for (int n = 0; n < 2; ++n) _Pragma("unroll") for (int k = 0; k < 2; ++k) \
        acc[ai][bj][m][n] = __builtin_amdgcn_mfma_f32_16x16x32_bf16(Bt[n][k], At[m][k], acc[ai][bj][m][n], 0, 0, 0); __builtin_amdgcn_s_setprio(0); } while (0)
#define PG8_WAIT_V(n) asm volatile("s_waitcnt vmcnt(" #n ")" ::: "memory")
#define PG8_WAIT_L(n) asm volatile("s_waitcnt lgkmcnt(" #n ")" ::: "memory")
#define PG8_BAR __builtin_amdgcn_s_barrier()
#define PG8_SCHED __builtin_amdgcn_sched_barrier(0)
    Unit cur, nxt; int ui = 0;
    if (!S.next(0, cur)) return;
    f32x4 acc[2][2][4][2];
#pragma unroll
    for (int a = 0; a < 2; ++a)
#pragma unroll
        for (int b = 0; b < 2; ++b)
#pragma unroll
            for (int m = 0; m < 4; ++m)
#pragma unroll
                for (int n = 0; n < 2; ++n) acc[a][b][m][n] = (f32x4){0.f, 0.f, 0.f, 0.f};
    bf16x8 At[4][2], B0[2][2], B1[2][2];
    const char* cA = (const char*)(cur.z ? g.A1 : g.A) + (size_t)cur.pm * tstep; const char* cB = (const char*)(cur.z ? g.Bt1 : g.Bt) + (size_t)cur.pn * tstep;
    S.a_ready(cur);
    if constexpr (SP2) {
        PG8_STAGE(PG8_SB(0, 0), cB, voffB); PG8_STAGE(PG8_SB(0, 1), cB + hstep, voffB); PG8_STAGE(PG8_SA(0, 0), cA, voffA); PG8_STAGE(PG8_SA(0, 1), cA + hstep, voffA);
        if (wr == 1) PG8_BAR;
        PG8_WAIT_V(2); PG8_BAR;
        PG8_STAGE(PG8_SB(1, 0), cB + kstep, voffB); PG8_STAGE(PG8_SA(1, 0), cA + kstep, voffA); PG8_STAGE(PG8_SB(1, 1), cB + hstep + kstep, voffB);
        PG8_WAIT_V(6); PG8_BAR;
    } else {
        PG8_STAGE(PG8_SB(0, 0), cB, voffB); PG8_STAGE(PG8_SA(0, 0), cA, voffA); PG8_STAGE(PG8_SB(0, 1), cB + hstep, voffB); PG8_STAGE(PG8_SA(0, 1), cA + hstep, voffA);
        if (wr == 1) PG8_BAR;
        PG8_WAIT_V(4); PG8_BAR;
        PG8_STAGE(PG8_SB(1, 0), cB + kstep, voffB); PG8_STAGE(PG8_SA(1, 0), cA + kstep, voffA); PG8_STAGE(PG8_SB(1, 1), cB + hstep + kstep, voffB);
        PG8_WAIT_V(6); PG8_BAR;
    }
    for (;;) {
        const bool has_next = S.next(ui + 1, nxt);
        const char* nA = has_next ? (const char*)(nxt.z ? g.A1 : g.A) + (size_t)nxt.pm * tstep : cA; const char* nB = has_next ? (const char*)(nxt.z ? g.Bt1 : g.Bt) + (size_t)nxt.pn * tstep : cB;
        for (int t = 0; t < nt; t += 2) {
            const bool last = (t == nt - 2);
            const char* a1 = cA + (size_t)(t + 1) * kstep;
            const char* a2 = last ? nA : cA + (size_t)(t + 2) * kstep; const char* b2 = last ? nB : cB + (size_t)(t + 2) * kstep;
            const char* a3 = a2 + kstep; const char* b3 = b2 + kstep;
            if (last && has_next) S.a_ready(nxt);
            if constexpr (SP2) {
            PG8_LDB(B0, 0, 0); PG8_LDB(B1, 0, 1); PG8_SCHED; PG8_LDA(At, 0, 0); PG8_STAGE(PG8_SA(1, 1), a1 + hstep, voffA);
            PG8_WAIT_V(8); PG8_WAIT_L(0); PG8_BAR; PG8_MMA(0, 0, At, B0); PG8_MMA(0, 1, At, B1); PG8_BAR; PG8_SCHED;
            PG8_LDA(At, 0, 1); PG8_STAGE(PG8_SB(0, 0), b2, voffB); PG8_STAGE(PG8_SB(0, 1), b2 + hstep, voffB); PG8_STAGE(PG8_SA(0, 0), a2, voffA);
            PG8_WAIT_V(8); PG8_WAIT_L(0); PG8_BAR; PG8_MMA(1, 0, At, B0); PG8_MMA(1, 1, At, B1); PG8_BAR; PG8_SCHED;
            PG8_LDB(B0, 1, 0); PG8_LDB(B1, 1, 1); PG8_SCHED; PG8_LDA(At, 1, 0); PG8_STAGE(PG8_SA(0, 1), a2 + hstep, voffA);
            PG8_WAIT_V(8); PG8_WAIT_L(0); PG8_BAR; PG8_MMA(0, 0, At, B0); PG8_MMA(0, 1, At, B1); PG8_BAR; PG8_SCHED;
            PG8_LDA(At, 1, 1); PG8_STAGE(PG8_SB(1, 0), b3, voffB); PG8_STAGE(PG8_SB(1, 1), b3 + hstep, voffB); PG8_STAGE(PG8_SA(1, 0), a3, voffA);
            PG8_WAIT_V(8); PG8_WAIT_L(0); PG8_BAR; PG8_MMA(1, 0, At, B0); PG8_MMA(1, 1, At, B1); PG8_BAR; PG8_SCHED;
            } else {
            PG8_LDB(B0, 0, 0); PG8_SCHED; PG8_LDA(At, 0, 0); PG8_STAGE(PG8_SA(1, 1), a1 + hstep, voffA);
            PG8_WAIT_L(8); PG8_BAR; PG8_WAIT_L(0); PG8_MMA(0, 0, At, B0); PG8_BAR; PG8_SCHED;
            PG8_LDB(B1, 0, 1); PG8_STAGE(PG8_SB(0, 0), b2, voffB);
            PG8_BAR; PG8_WAIT_L(0); PG8_MMA(0, 1, At, B1); PG8_BAR;
            PG8_LDA(At, 0, 1); PG8_STAGE(PG8_SA(0, 0), a2, voffA);
            PG8_BAR; PG8_WAIT_L(0); PG8_MMA(1, 0, At, B0); PG8_BAR; PG8_SCHED;
            PG8_STAGE(PG8_SB(0, 1), b2 + hstep, voffB);
            PG8_WAIT_V(6); PG8_BAR; PG8_MMA(1, 1, At, B1); PG8_BAR;
            PG8_LDB(B0, 1, 0); PG8_SCHED; PG8_LDA(At, 1, 0); PG8_STAGE(PG8_SA(0, 1), a2 + hstep, voffA);
            PG8_WAIT_L(8); PG8_BAR; PG8_WAIT_L(0); PG8_MMA(0, 0, At, B0); PG8_BAR; PG8_SCHED;
            PG8_LDB(B1, 1, 1); PG8_STAGE(PG8_SB(1, 0), b3, voffB);
            PG8_BAR; PG8_WAIT_L(0); PG8_MMA(0, 1, At, B1); PG8_BAR;
            PG8_LDA(At, 1, 1); PG8_STAGE(PG8_SA(1, 0), a3, voffA);
            PG8_BAR; PG8_WAIT_L(0); PG8_MMA(1, 0, At, B0); PG8_BAR; PG8_SCHED;
            PG8_STAGE(PG8_SB(1, 1), b3 + hstep, voffB);
            PG8_WAIT_V(6); PG8_BAR; PG8_MMA(1, 1, At, B1); PG8_BAR;
            }
        }
        if constexpr (ALIGN_EPI) { if (wr == 0) PG8_BAR; }
        if constexpr (!Epi::AFTER_DRAIN) { E(acc, cur, wr, wc, fr, fq); S.done(cur); }
        if (!has_next) break;
#pragma unroll
        for (int a = 0; a < 2; ++a)
#pragma unroll
            for (int b = 0; b < 2; ++b)
#pragma unroll
                for (int m = 0; m < 4; ++m)
#pragma unroll
                    for (int n = 0; n < 2; ++n) acc[a][b][m][n] = (f32x4){0.f, 0.f, 0.f, 0.f};
        cur = nxt; cA = nA; cB = nB; ++ui;
        if constexpr (ALIGN_EPI) { if (wr == 1) PG8_BAR; }
    }
    PG8_WAIT_V(0);
    if constexpr (!ALIGN_EPI) { if (wr == 0) PG8_BAR; }
    PG8_BAR;
    if constexpr (Epi::AFTER_DRAIN) { E.fused(acc, cur, wr, wc, fr, fq, lds, wid, lane); S.done(cur); }
#undef PG8_SA
#undef PG8_SB
#undef PG8_STAGE
#undef PG8_LDA
#undef PG8_LDB
#undef PG8_MMA
#undef PG8_WAIT_V
#undef PG8_WAIT_L
#undef PG8_BAR
#undef PG8_SCHED
}
}

#define GAS __attribute__((address_space(1)))
#define LAS __attribute__((address_space(3)))
typedef unsigned short bf16;
typedef unsigned v4u __attribute__((ext_vector_type(4)));
typedef float f32x4 __attribute__((ext_vector_type(4)));
typedef short bf16x8 __attribute__((ext_vector_type(8)));
typedef GAS unsigned gu32;
typedef GAS unsigned long long gu64;
#define RLX_AGENT __ATOMIC_RELAXED, __HIP_MEMORY_SCOPE_AGENT
#define LDS_WAIT() asm volatile("s_waitcnt lgkmcnt(0)" ::: "memory")
#define VM_WAIT() asm volatile("s_waitcnt vmcnt(0)" ::: "memory")
__device__ __forceinline__ unsigned long long rt() { return __builtin_amdgcn_s_memrealtime(); }
__device__ __forceinline__ unsigned f2bf(float f) { unsigned u = __builtin_bit_cast(unsigned, f); return (u + 0x7fffu + ((u >> 16) & 1u)) >> 16; }
__device__ __forceinline__ unsigned pk2(float lo, float hi) { return f2bf(lo) | (f2bf(hi) << 16); }
#define XB_TMO      128
#define XB_XCNT(j)  (256  + 64 * (j))
#define XB_XSUB(j)  (1280 + 64 * (j))
#define XB_XGEN(j)  (2304 + 64 * (j))
#define XB_TOP      3328
#define XB_TOPGEN   3392
#define XCD_BAR_WORDS 3456
#define XB_SPIN_CAP (1u << 18)

__device__ __forceinline__ unsigned xb_ld(unsigned* p)              { return __hip_atomic_load(p, __ATOMIC_RELAXED, __HIP_MEMORY_SCOPE_AGENT); }
__device__ __forceinline__ unsigned xb_add(unsigned* p, unsigned v) { return __hip_atomic_fetch_add(p, v, __ATOMIC_RELAXED, __HIP_MEMORY_SCOPE_AGENT); }
__device__ __forceinline__ unsigned xb_xcc_id() { return (unsigned)__builtin_amdgcn_s_getreg((3 << 11) | 20) & 0xFu; }
#define XB_SPIN(cond, bar) do { unsigned _sp = 0; while (cond) { __builtin_amdgcn_s_sleep(1); \
    if ((++_sp & 255u) == 0u) { if (xb_ld(&(bar)[XB_TMO])) break; if (_sp > XB_SPIN_CAP) { atomicAdd(&(bar)[XB_TMO], 1u); break; } } } } while (0)

struct XcdBarrier {
    unsigned* bar; unsigned x;
    volatile LAS unsigned* st;
};

__device__ __forceinline__ XcdBarrier xcd_barrier_post(unsigned* bar, volatile LAS unsigned* st) {
    XcdBarrier b; b.bar = bar; b.x = xb_xcc_id(); b.st = st;
    if (threadIdx.x == 0) (void)xb_add(&bar[XB_XCNT(b.x)], 1u);
    return b;
}
__device__ __forceinline__ void xcd_barrier_complete(unsigned* bar, unsigned x, unsigned& nloc, unsigned& nx) {
    const unsigned G = gridDim.x * gridDim.y * gridDim.z;
    unsigned sum, cnt, mine, sp = 0u;
    for (;;) {
        sum = 0u; cnt = 0u; mine = 0u;
#pragma unroll
        for (unsigned j = 0; j < 16; ++j) { const unsigned c = xb_ld(&bar[XB_XCNT(j)]); sum += c; cnt += (c > 0u) ? 1u : 0u; mine = (j == x) ? c : mine; }
        if (sum == G) break;
        __builtin_amdgcn_s_sleep(1);
        if ((++sp & 255u) == 0u) { if (xb_ld(&bar[XB_TMO])) break; if (sp > XB_SPIN_CAP) { atomicAdd(&bar[XB_TMO], 1u); break; } }
    }
    nloc = mine > 0u ? mine : 1u; nx = cnt > 0u ? cnt : 1u;
}

__device__ __forceinline__ void xcd_barrier(const XcdBarrier& b) {
    asm volatile("s_waitcnt vmcnt(0)" ::: "memory");
    __syncthreads();
    if (threadIdx.x == 0) {
        unsigned* bar = b.bar;
        __builtin_amdgcn_s_waitcnt(0);
        unsigned nloc = b.st[0], nx = b.st[1];
        if (nloc == 0u) { xcd_barrier_complete(bar, b.x, nloc, nx); b.st[0] = nloc; b.st[1] = nx; }
        const unsigned old = xb_add(&bar[XB_XSUB(b.x)], 1u);
        const unsigned gen = old / nloc;
        if (old + 1u == (gen + 1u) * nloc) {
            __builtin_amdgcn_fence(__ATOMIC_RELEASE, "agent");
            asm volatile("s_waitcnt vmcnt(0)" ::: "memory");
            const unsigned og = xb_add(&bar[XB_TOP], 1u);
            const unsigned tg = og / nx;
            if (og + 1u == (tg + 1u) * nx) xb_add(&bar[XB_TOPGEN], 1u);
            else XB_SPIN(xb_ld(&bar[XB_TOPGEN]) == tg, bar);
            __builtin_amdgcn_fence(__ATOMIC_ACQUIRE, "agent");
            xb_add(&bar[XB_XGEN(b.x)], 1u);
            asm volatile("s_waitcnt vmcnt(0)" ::: "memory");
        } else {
            XB_SPIN(xb_ld(&bar[XB_XGEN(b.x)]) == gen, bar);
            __builtin_amdgcn_fence(__ATOMIC_ACQUIRE, "agent");
            asm volatile("s_waitcnt vmcnt(0)" ::: "memory");
        }
    }
    __syncthreads();
}

constexpr int NWAVES = 8;
#ifndef MK_N_LAUNCHES
#define MK_N_LAUNCHES 1
#endif
constexpr int N_PHASES = 12;
constexpr int N_LAUNCHES = MK_N_LAUNCHES;

constexpr int M = 16384, SEQ = 2048, D = 1024, FF = 2816, NGU = 2 * FF, NIN = 8704, NATT = 4608, NHG = 2048, NGATE = 2048;
constexpr float EPS = 1e-6f;

constexpr size_t MiB = 1u << 20;
constexpr size_t WS_CTL = 0, CTL_ZERO_BYTES = 1 * MiB;
constexpr size_t WS_SS = 1 * MiB;
constexpr size_t WS_WGU1 = 2 * MiB, WS_WD1 = 13 * MiB, WS_WGU2 = 18 * MiB + 512 * 1024, WS_WD2 = 29 * MiB + 512 * 1024, WS_WIN = 35 * MiB, WS_WA = 52 * MiB, WS_WB = 53 * MiB, WS_WO = 54 * MiB;
constexpr size_t WS_HB = 56 * MiB;
constexpr size_t WS_BIG = 88 * MiB;
constexpr size_t WS_HID = WS_BIG;
constexpr size_t WS_AQKV = WS_BIG, WS_YB = 232 * MiB;
constexpr size_t WS_HQ = WS_BIG, WS_GATES = 152 * MiB, WS_YA = 216 * MiB;
constexpr size_t WS_TMP = WS_BIG, WS_MERGED = 120 * MiB;
constexpr size_t WS_END = 256 * MiB;
static_assert(WS_WGU1 + (size_t)NGU * D * 2 <= WS_WD1 && WS_WD1 + (size_t)D * FF * 2 <= WS_WGU2 && WS_WGU2 + (size_t)NGU * D * 2 <= WS_WD2 && WS_WD2 + (size_t)D * FF * 2 <= WS_WIN && WS_WIN + (size_t)NIN * D * 2 <= WS_WA, "ws map: weights");
static_assert(WS_HB + (size_t)M * D * 2 <= WS_BIG && WS_HID + (size_t)M * FF * 2 <= WS_END && WS_AQKV + (size_t)M * NATT * 2 <= WS_YB && WS_YB + (size_t)M * 512 * 2 <= WS_END, "ws map: acts");
static_assert(WS_HQ + (size_t)M * NHG * 2 <= WS_GATES && WS_GATES + (size_t)M * NGATE * 2 <= WS_YA && WS_YA + (size_t)M * 512 * 2 <= WS_YB && WS_TMP + (size_t)M * D * 2 <= WS_MERGED && WS_MERGED + (size_t)M * D * 2 <= WS_GATES, "ws map: mixer");
constexpr int CW_BAR = 4096;

constexpr int RING_OFF = 0, RING_BYTES = 131072;
constexpr int LDSCTL_OFF = RING_BYTES, MISC_OFF = LDSCTL_OFF + 320;
constexpr int LDS_BYTES = 147456;

__device__ __forceinline__ float bf2f(bf16 x) { return __uint_as_float((unsigned)x << 16); }
__device__ __forceinline__ float wave_sum(float v) {
#pragma unroll
    for (int o = 1; o < 64; o <<= 1) v += __shfl_xor(v, o);
    return v;
}
__device__ __forceinline__ float wave_max(float v) {
#pragma unroll
    for (int o = 1; o < 64; o <<= 1) v = fmaxf(v, __shfl_xor(v, o));
    return v;
}
__device__ __forceinline__ float sigmoidf_(float x) { return 1.0f / (1.0f + __expf(-x)); }

__device__ __forceinline__ void p0_transpose_item(const float* W, const float* gain, int K, int N, bf16* WT, int mapmode, LAS float* scr, int item, int lane) {
    const int nblk = N / 32, kb = item / nblk, nb = item % nblk, k0 = 64 * kb, n0 = 32 * nb;
    int d0;
    if (mapmode == 1) { const int bj = n0 >= FF ? 1 : 0, c = n0 - bj * FF; d0 = (c >> 7) * 256 + bj * 128 + (c & 127); }
    else if (mapmode == 2) { d0 = n0 < 2048 ? n0 : (n0 < 6656 ? 4096 + (n0 - 2048) : 2048 + (n0 - 6656)); }
    else d0 = n0;
#pragma unroll 8
    for (int i = 0; i < 32; ++i) { const int kk = 2 * i + (lane >> 5); const float g = gain ? gain[k0 + kk] : 1.0f; scr[kk * 33 + (lane & 31)] = W[(size_t)(k0 + kk) * N + n0 + (lane & 31)] * g; }
    LDS_WAIT(); asm volatile("" ::: "memory");
    const int c = lane & 7;
#pragma unroll
    for (int j = 0; j < 4; ++j) { const int n = (lane >> 3) + 8 * j; const LAS float* s = scr + (8 * c) * 33 + n;
        v4u o; o.x = pk2(s[0 * 33], s[1 * 33]); o.y = pk2(s[2 * 33], s[3 * 33]); o.z = pk2(s[4 * 33], s[5 * 33]); o.w = pk2(s[6 * 33], s[7 * 33]);
        *(GAS v4u*)(WT + (size_t)(d0 + n) * K + k0 + 8 * c) = o; }
    LDS_WAIT(); asm volatile("" ::: "memory");
}

__device__ __forceinline__ void hgrn_naive(const bf16* HQ, const float* lbraw, const float* onorm, bf16* YA, LAS unsigned char* lds, int tid) {
    if (blockIdx.x >= 16) return;
    constexpr int TB = 8;
    LAS f32x4* L4 = (LAS f32x4*)lds;
    LAS float* OB = (LAS float*)(lds + 2 * TB * 128 * 16);
    LAS float* WSUM = OB + 2 * TB * 2 * 128;
    const int cw = tid >> 8, kh = (tid >> 7) & 1, v = tid & 127, lane = tid & 63, wv = (tid >> 6) & 1;
    const int chain = blockIdx.x * 2 + cw, b = chain >> 2, h = chain & 3;
    const float a0 = lbraw[h * 128 + v], a1 = lbraw[512 + h * 128 + v];
    const float lb = 1.0f / (1.0f + __expf(a1 - a0));
    const float gain = onorm[h * 128 + v];
    float S[64];
#pragma unroll
    for (int k = 0; k < 64; ++k) S[k] = 0.f;
    for (int t0 = 0; t0 < SEQ; t0 += TB) {
#pragma unroll 1
        for (int tt = kh; tt < TB; tt += 2) {
            const size_t row = (size_t)b * SEQ + t0 + tt;
            const float qv = bf2f(HQ[row * 2048 + h * 128 + v]), fp = bf2f(HQ[row * 2048 + 512 + h * 128 + v]);
            const float f = lb + (1.0f - lb) * sigmoidf_(fp);
            L4[(cw * TB + tt) * 128 + v] = (f32x4){qv, f, 1.0f - f, 0.f};
        }
        __syncthreads();
#pragma unroll 1
        for (int tt = 0; tt < TB; ++tt) {
            const size_t row = (size_t)b * SEQ + t0 + tt;
            const float iv = bf2f(HQ[row * 2048 + 1024 + h * 128 + v]);
            float ot = 0.f;
#pragma unroll
            for (int kg = 0; kg < 8; ++kg) {
#pragma unroll
                for (int k8 = 0; k8 < 8; ++k8) { const int k = kg * 8 + k8; const f32x4 e = L4[(cw * TB + tt) * 128 + kh * 64 + k]; S[k] = e[1] * S[k] + e[2] * iv; ot += e[0] * S[k]; }
                __builtin_amdgcn_sched_barrier(0);
            }
            OB[((cw * TB + tt) * 2 + kh) * 128 + v] = ot;
        }
        __syncthreads();
        float o4[4];
#pragma unroll
        for (int i = 0; i < 4; ++i) {
            const int tt = 2 * i + kh;
            o4[i] = OB[((cw * TB + tt) * 2 + 0) * 128 + v] + OB[((cw * TB + tt) * 2 + 1) * 128 + v];
            const float sq = wave_sum(o4[i] * o4[i]);
            if (lane == 0) WSUM[(cw * TB + tt) * 2 + wv] = sq;
        }
        __syncthreads();
#pragma unroll
        for (int i = 0; i < 4; ++i) {
            const int tt = 2 * i + kh;
            const size_t row = (size_t)b * SEQ + t0 + tt;
            const float tot = WSUM[(cw * TB + tt) * 2] + WSUM[(cw * TB + tt) * 2 + 1];
            const float rs = rsqrtf(tot * (1.0f / 128.0f) + EPS);
            const float og = bf2f(HQ[row * 2048 + 1536 + h * 128 + v]);
            const float y = o4[i] * rs * gain * (og * sigmoidf_(og));
            YA[row * 512 + h * 128 + v] = (bf16)f2bf(y);
        }
        __syncthreads();
    }
}

__device__ __forceinline__ void attn_naive(const bf16* AQKV, bf16* YB, LAS float* wq, int gw, int NGW, int lane) {
    for (int unit = gw; unit < M * 8; unit += NGW) {
        const int row = unit >> 3, hs = unit & 7, b = row >> 11, s = row & (SEQ - 1);
        float m_run = -1e30f, l_run = 0.f, acc = 0.f;
#pragma unroll 1
        for (int g = 0; g < 3; ++g) {
            const int d = g == 0 ? 1 : (g == 1 ? 4 : 16);
            const float slope = exp2f(-8.0f * (float)(g * 8 + hs + 1) / 24.0f);
            const int qcol = g * 1536 + hs * 64, kcol = qcol + 512, vcol = qcol + 1024;
            wq[lane] = bf2f(AQKV[(size_t)row * NATT + qcol + lane]) * 0.125f;
            const int lq = s / d, nk = (lq < 128 ? lq : 128) + 1;
#pragma unroll 1
            for (int c0 = 0; c0 < nk; c0 += 64) {
                const int j = c0 + lane; const bool valid = j < nk;
                float sc = -1e30f;
                if (valid) {
                    const bf16* kr = AQKV + (size_t)(b * SEQ + s - j * d) * NATT + kcol;
                    float dot = 0.f;
#pragma unroll
                    for (int e8 = 0; e8 < 8; ++e8) {
                        const v4u w = *(const v4u*)(kr + e8 * 8);
                        dot += wq[e8 * 8 + 0] * __uint_as_float(w.x << 16) + wq[e8 * 8 + 1] * __uint_as_float(w.x & 0xffff0000u)
                             + wq[e8 * 8 + 2] * __uint_as_float(w.y << 16) + wq[e8 * 8 + 3] * __uint_as_float(w.y & 0xffff0000u)
                             + wq[e8 * 8 + 4] * __uint_as_float(w.z << 16) + wq[e8 * 8 + 5] * __uint_as_float(w.z & 0xffff0000u)
                             + wq[e8 * 8 + 6] * __uint_as_float(w.w << 16) + wq[e8 * 8 + 7] * __uint_as_float(w.w & 0xffff0000u);
                    }
                    sc = dot - slope * (float)(d * j);
                }
                const float m_new = fmaxf(m_run, wave_max(sc));
                const float p = valid ? __expf(sc - m_new) : 0.f;
                const float corr = __expf(m_run - m_new);
                l_run = l_run * corr + wave_sum(p); acc *= corr; m_run = m_new;
                const int cnt = (nk - c0) < 64 ? (nk - c0) : 64;
#pragma unroll 1
                for (int jj = 0; jj < cnt; ++jj) {
                    const float pj = __uint_as_float(__builtin_amdgcn_readlane(__float_as_uint(p), jj));
                    acc += pj * bf2f(AQKV[(size_t)(b * SEQ + s - (c0 + jj) * d) * NATT + vcol + lane]);
                }
            }
        }
        YB[(size_t)row * 512 + hs * 64 + lane] = (bf16)f2bf(acc / l_run);
    }
}

struct Args { const float* in[15]; float* out; unsigned char* ws; int ph_lo, ph_hi, li, pad; };
__global__ void __launch_bounds__(NWAVES * 64, 2) mk_fwd(Args args) {
    __shared__ __attribute__((aligned(16))) unsigned char lds_raw[LDS_BYTES];
    LAS unsigned char* lds = (LAS unsigned char*)lds_raw;
    volatile LAS unsigned* MISC = (volatile LAS unsigned*)(lds + MISC_OFF);
    const int tid = threadIdx.x, lane = tid & 63, wave = __builtin_amdgcn_readfirstlane(tid >> 6);
    const int G = gridDim.x; const int bx = blockIdx.x; const int vcu = (G % 8 == 0) ? (bx % 8) * (G / 8) + bx / 8 : bx;
    const int gw = vcu * NWAVES + wave, NGW = G * NWAVES;
    unsigned char* ws = args.ws;
    gu32* ctl = (gu32*)(ws + WS_CTL);
    const float* x = args.in[0]; const float* ffn1_norm = args.in[1]; const float* ffn1_wgu = args.in[2]; const float* ffn1_wd = args.in[3]; const float* mix_norm = args.in[4];
    const float* w_in = args.in[5]; const float* hg_lb = args.in[6]; const float* hg_onorm = args.in[7]; const float* w_bhg = args.in[8]; const float* w_batt = args.in[9];
    const float* w_out = args.in[10]; const float* ffn2_norm = args.in[11]; const float* ffn2_wgu = args.in[12]; const float* ffn2_wd = args.in[13]; const float* final_norm = args.in[14];
    float* out = args.out;
    float* SS = (float*)(ws + WS_SS);
    bf16* WGU1 = (bf16*)(ws + WS_WGU1); bf16* WD1 = (bf16*)(ws + WS_WD1); bf16* WGU2 = (bf16*)(ws + WS_WGU2); bf16* WD2 = (bf16*)(ws + WS_WD2);
    bf16* WIN = (bf16*)(ws + WS_WIN); bf16* WA = (bf16*)(ws + WS_WA); bf16* WB = (bf16*)(ws + WS_WB); bf16* WO = (bf16*)(ws + WS_WO);
    bf16* HB = (bf16*)(ws + WS_HB); bf16* HID = (bf16*)(ws + WS_HID); bf16* AQKV = (bf16*)(ws + WS_AQKV); bf16* YB = (bf16*)(ws + WS_YB);
    bf16* HQ = (bf16*)(ws + WS_HQ); bf16* GATES = (bf16*)(ws + WS_GATES); bf16* YA = (bf16*)(ws + WS_YA); bf16* TMP = (bf16*)(ws + WS_TMP); bf16* MERGED = (bf16*)(ws + WS_MERGED);

    for (int u = tid; u < (LDS_BYTES - LDSCTL_OFF) / 4; u += NWAVES * 64) ((LAS unsigned*)(lds + LDSCTL_OFF))[u] = 0u;
    __syncthreads();
    XcdBarrier bar; bar.bar = (unsigned*)(ctl + CW_BAR); bar.x = 0; bar.st = nullptr;
    if (N_LAUNCHES == 1) bar = xcd_barrier_post((unsigned*)(ctl + CW_BAR), MISC + 8);
    const int lo = args.ph_lo, hi = args.ph_hi;
#define IN(k) (lo <= (k) && (k) < hi)
#define SEAM(k) do { if (IN(k) && IN((k) + 1)) xcd_barrier(bar); } while (0)

    if (IN(0)) {
        LAS float* scr = (LAS float*)(lds + RING_OFF + wave * 16384);
        constexpr int I_GU = (D / 64) * (NGU / 32), I_DN = (FF / 64) * (D / 32), I_IN = (D / 64) * (NIN / 32), I_BR = (512 / 64) * (D / 32), I_WO = (D / 64) * (D / 32);
        constexpr int NITEMS = 2 * I_GU + 2 * I_DN + I_IN + 2 * I_BR + I_WO;
        for (int it = gw; it < NITEMS; it += NGW) {
            int r = it;
            if (r < I_GU) { p0_transpose_item(ffn1_wgu, ffn1_norm, D, NGU, WGU1, 1, scr, r, lane); continue; } r -= I_GU;
            if (r < I_GU) { p0_transpose_item(ffn2_wgu, ffn2_norm, D, NGU, WGU2, 1, scr, r, lane); continue; } r -= I_GU;
            if (r < I_DN) { p0_transpose_item(ffn1_wd, nullptr, FF, D, WD1, 0, scr, r, lane); continue; } r -= I_DN;
            if (r < I_DN) { p0_transpose_item(ffn2_wd, nullptr, FF, D, WD2, 0, scr, r, lane); continue; } r -= I_DN;
            if (r < I_IN) { p0_transpose_item(w_in, mix_norm, D, NIN, WIN, 2, scr, r, lane); continue; } r -= I_IN;
            if (r < I_BR) { p0_transpose_item(w_bhg, nullptr, 512, D, WA, 0, scr, r, lane); continue; } r -= I_BR;
            if (r < I_BR) { p0_transpose_item(w_batt, nullptr, 512, D, WB, 0, scr, r, lane); continue; } r -= I_BR;
            p0_transpose_item(w_out, nullptr, D, D, WO, 0, scr, r, lane);
        }
        for (int m = gw; m < M; m += NGW) {
            const GAS f32x4* xr = (const GAS f32x4*)(x + (size_t)m * D) + lane;
            f32x4 v[4]; float s = 0.f;
#pragma unroll
            for (int j = 0; j < 4; ++j) { v[j] = xr[64 * j]; s += (v[j].x * v[j].x + v[j].y * v[j].y) + (v[j].z * v[j].z + v[j].w * v[j].w); }
            s = wave_sum(s);
            if (lane == 0) SS[m] = s;
            GAS unsigned long long* o8 = (GAS unsigned long long*)(HB + (size_t)m * D) + lane;
#pragma unroll
            for (int j = 0; j < 4; ++j) o8[64 * j] = (unsigned long long)pk2(v[j].x, v[j].y) | ((unsigned long long)pk2(v[j].z, v[j].w) << 32);
        }
        for (int i = vcu * (NWAVES * 64) + tid; i < 3 * M; i += G * NWAVES * 64) SS[M + i] = 0.f;
    }
    SEAM(0);
    if (IN(1)) {
        pg8::Gemm g{HB, WGU1, HB, WGU1, D}; pg8::StaticOrder S; S.init(M, NGU, G, bx);
        pg8::EpiSwiGLU E{HID, SS, FF};
        pg8::gemm_phase<pg8::EpiSwiGLU, pg8::StaticOrder, true, true>(lds + RING_OFF, g, S, E);
    }
    SEAM(1);
    if (IN(2)) {
        pg8::Gemm g{HID, WD1, HID, WD1, FF}; pg8::StaticOrder S; S.init(M, D, G, bx);
        pg8::EpiResid E{x, out, HB, SS + M, 0.5f};
        pg8::gemm_phase<pg8::EpiResid, pg8::StaticOrder, true, true>(lds + RING_OFF, g, S, E);
    }
    SEAM(2);
    if (IN(3)) {
        pg8::Gemm g{HB, WIN + (size_t)4096 * D, HB, WIN + (size_t)4096 * D, D}; pg8::StaticOrder S; S.init(M, NATT, G, bx);
        pg8::EpiProj E{AQKV, NATT, AQKV, NATT, 1 << 30, SS + M};
        pg8::gemm_phase<pg8::EpiProj, pg8::StaticOrder, true, true>(lds + RING_OFF, g, S, E);
    }
    SEAM(3);
    if (IN(4)) { attn_naive(AQKV, YB, (LAS float*)(lds + RING_OFF) + wave * 64, gw, NGW, lane); }
    SEAM(4);
    if (IN(5)) {
        pg8::Gemm g{HB, WIN, HB, WIN, D}; pg8::StaticOrder S; S.init(M, NHG + NGATE, G, bx);
        pg8::EpiProj E{HQ, NHG, GATES, NGATE, NHG / 256, SS + M};
        pg8::gemm_phase<pg8::EpiProj, pg8::StaticOrder, true, true>(lds + RING_OFF, g, S, E);
    }
    SEAM(5);
    if (IN(6)) { hgrn_naive(HQ, hg_lb, hg_onorm, YA, lds + RING_OFF, tid); }
    SEAM(6);
    if (IN(7)) {
        pg8::Gemm g{YA, WA, YB, WB, 512}; pg8::MergeOrder S; S.init(M, D, G, bx);
        pg8::EpiMerge E{GATES, TMP, MERGED};
        pg8::gemm_phase<pg8::EpiMerge, pg8::MergeOrder, true, true>(lds + RING_OFF, g, S, E);
    }
    SEAM(7);
    if (IN(8)) {
        pg8::Gemm g{MERGED, WO, MERGED, WO, D}; pg8::StaticOrder S; S.init(M, D, G, bx);
        pg8::EpiResid E{out, out, HB, SS + 2 * M, 1.0f};
        pg8::gemm_phase<pg8::EpiResid, pg8::StaticOrder, true, true>(lds + RING_OFF, g, S, E);
    }
    SEAM(8);
    if (IN(9)) {
        pg8::Gemm g{HB, WGU2, HB, WGU2, D}; pg8::StaticOrder S; S.init(M, NGU, G, bx);
        pg8::EpiSwiGLU E{HID, SS + 2 * M, FF};
        pg8::gemm_phase<pg8::EpiSwiGLU, pg8::StaticOrder, true, true>(lds + RING_OFF, g, S, E);
    }
    SEAM(9);
    if (IN(10)) {
        pg8::Gemm g{HID, WD2, HID, WD2, FF}; pg8::StaticOrder S; S.init(M, D, G, bx);
        pg8::EpiResid E{out, out, HB, SS + 3 * M, 0.5f};
        pg8::gemm_phase<pg8::EpiResid, pg8::StaticOrder, true, true>(lds + RING_OFF, g, S, E);
    }
    SEAM(10);
    if (IN(11)) {
        for (int m = gw; m < M; m += NGW) {
            GAS f32x4* r = (GAS f32x4*)(out + (size_t)m * D) + lane; const GAS f32x4* gn = (const GAS f32x4*)final_norm + lane;
            const float rs = rsqrtf(SS[3 * M + m] * (1.0f / D) + EPS);
#pragma unroll
            for (int j = 0; j < 4; ++j) { f32x4 v = r[64 * j]; v = v * rs * gn[64 * j]; r[64 * j] = v; }
        }
    }
#undef IN
#undef SEAM
}

extern "C" void kernel_launch(void* const* d_in, const int* in_sizes, int n_in, void* d_out, int out_size, void* d_ws, size_t ws_size, hipStream_t stream) {
    static int grid = 0;
    if (grid == 0) {
        if (n_in != 15 || out_size != M * D || ws_size < WS_END) { fprintf(stderr, "kernel_launch: unexpected shapes (n_in %d out %d ws %zu)\n", n_in, out_size, ws_size); grid = -1; return; }
        int dev = 0, cus = 0;
        if (hipGetDevice(&dev) != hipSuccess || hipDeviceGetAttribute(&cus, hipDeviceAttributeMultiprocessorCount, dev) != hipSuccess) { grid = -1; return; }
        grid = cus;
    }
    if (grid < 0) return;
    if (hipMemsetAsync((char*)d_ws + WS_CTL, 0, CTL_ZERO_BYTES, stream) != hipSuccess) return;
    Args a{};
    for (int i = 0; i < 15; ++i) a.in[i] = (const float*)d_in[i];
    a.out = (float*)d_out; a.ws = (unsigned char*)d_ws;
    for (int li = 0; li < N_LAUNCHES; ++li) {
        a.ph_lo = (N_LAUNCHES == 1) ? 0 : li; a.ph_hi = (N_LAUNCHES == 1) ? N_PHASES : li + 1; a.li = li;
        hipLaunchKernelGGL(mk_fwd, dim3(grid), dim3(NWAVES * 64), 0, stream, a);
    }
}
```

```cpp
#include <hip/hip_runtime.h>
#include <cstdio>
#include <cstdint>
namespace pg8 {
#define PG8_LAS __attribute__((address_space(3)))
typedef unsigned short bf16_t;
typedef short bf16x8 __attribute__((ext_vector_type(8)));
typedef float f32x4 __attribute__((ext_vector_type(4)));
typedef unsigned u32x4 __attribute__((ext_vector_type(4)));
constexpr int BM = 256, BK = 64, HALF = 128, HTB = HALF * BK * 2  , STAGE_BYTES = 8 * HTB, NXCD = 8, WGM = 8;

__host__ __device__ __forceinline__ int lds_byte(int r, int c) { const int st = (r >> 4) * 2 + (c >> 5), rr = r & 15, cc = c & 31, ob = rr * 64 + cc * 2; return st * 1024 + (ob ^ (((ob >> 9) & 1) << 5)); }
__host__ __device__ __forceinline__ void stage_rc(int b, int& R, int& C) { const int st = b / 1024, sb = b % 1024, swz = sb ^ (((sb >> 9) & 1) << 5); R = (st >> 1) * 16 + swz / 64; C = (st & 1) * 32 + (swz % 64) / 2; }
__host__ __device__ __forceinline__ int perm32(int rho) { const int n = rho >> 4, i = rho & 15; return 8 * (i >> 2) + 4 * n + (i & 3); }

struct Unit { int pm, pn, z; };
struct Gemm { const bf16_t* A; const bf16_t* Bt; const bf16_t* A1; const bf16_t* Bt1; int K; };

struct StaticOrder {
    int nM, nN, nwg, G, c;
    __host__ __device__ void init(int M, int N, int G_, int c_) { nM = M / BM; nN = N / BM; nwg = nM * nN; G = G_; c = c_; }
    __host__ __device__ bool next(int i, Unit& u) const {
        const long L = (long)i * G + c; if (L >= nwg) return false;
        int wgid = (int)L; { const int q = nwg / NXCD, r = nwg % NXCD, xcd = wgid % NXCD, off = wgid / NXCD; wgid = (xcd < r ? xcd * (q + 1) : r * (q + 1) + (xcd - r) * q) + off; }
        const int nig = WGM * nN, gid = wgid / nig, fm = gid * WGM, gsz = (nM - fm) < WGM ? (nM - fm) : WGM;
        u.pm = fm + ((wgid % nig) % gsz); u.pn = (wgid % nig) / gsz; u.z = 0; return true;
    }
    __device__ __forceinline__ void a_ready(const Unit&) const {}
    __device__ __forceinline__ void done(const Unit&) const {}
};


__device__ __forceinline__ unsigned cvt_pk_bf16(float lo, float hi) { unsigned r; asm volatile("v_cvt_pk_bf16_f32 %0, %1, %2" : "=v"(r) : "v"(lo), "v"(hi)); return r; }
typedef float f32x2 __attribute__((ext_vector_type(2)));
__device__ __forceinline__ float fast_sigmoid(float x) { return __builtin_amdgcn_rcpf(1.0f + __builtin_amdgcn_exp2f(-1.4426950408889634f * x)); }
__device__ __forceinline__ float bf_lo(unsigned w) { return __uint_as_float(w << 16); }
__device__ __forceinline__ float bf_hi(unsigned w) { return __uint_as_float(w & 0xffff0000u); }
__device__ __forceinline__ float row_rstd(const float* ss, int row) { return rsqrtf(ss[row] * (1.0f / 1024.0f) + 1e-6f); }
__device__ __forceinline__ u32x4 pack8(const float (&h)[8]) { u32x4 w; w.x = cvt_pk_bf16(h[0], h[1]); w.y = cvt_pk_bf16(h[2], h[3]); w.z = cvt_pk_bf16(h[4], h[5]); w.w = cvt_pk_bf16(h[6], h[7]); return w; }

struct EpiSwiGLU {
    static constexpr bool PERM = true, AFTER_DRAIN = false;
    bf16_t* O; const float* ss; int ldo;
    __device__ __forceinline__ void operator()(const f32x4 (&acc)[2][2][4][2], const Unit& u, int wr, int wc, int fr, int fq) const {
        const int row0 = u.pm * BM + wr * 64 + fr, col0 = u.pn * 128 + wc * 32 + 8 * fq;
#pragma unroll
        for (int ai = 0; ai < 2; ++ai)
#pragma unroll
            for (int m = 0; m < 4; ++m) {
                const int row = row0 + ai * HALF + m * 16; const float rs = row_rstd(ss, row);
                float h[8];
#pragma unroll
                for (int n = 0; n < 2; ++n)
#pragma unroll
                    for (int i = 0; i < 4; ++i) { const float g = acc[ai][0][m][n][i] * rs, up = acc[ai][1][m][n][i] * rs; h[4 * n + i] = g * fast_sigmoid(g) * up; }
                *(u32x4*)(O + (size_t)row * ldo + col0) = pack8(h);
            }
    }
};
struct EpiResid {
    static constexpr bool PERM = true, AFTER_DRAIN = false;
    const float* base; float* outf; bf16_t* hb; float* ss_out; float scale;
    __device__ __forceinline__ void operator()(const f32x4 (&acc)[2][2][4][2], const Unit& u, int wr, int wc, int fr, int fq) const {
        const int row0 = u.pm * BM + wr * 64 + fr;
#pragma unroll
        for (int ai = 0; ai < 2; ++ai)
#pragma unroll
            for (int m = 0; m < 4; ++m) {
                const int row = row0 + ai * HALF + m * 16; float ssq = 0.f;
#pragma unroll
                for (int bj = 0; bj < 2; ++bj) {
                    const size_t off = (size_t)row * 1024 + u.pn * BM + bj * HALF + wc * 32 + 8 * fq;
                    const f32x4 b0 = *(const f32x4*)(base + off), b1 = *(const f32x4*)(base + off + 4);
                    const f32x4 v0 = b0 + acc[ai][bj][m][0] * scale, v1 = b1 + acc[ai][bj][m][1] * scale;
                    *(f32x4*)(outf + off) = v0; *(f32x4*)(outf + off + 4) = v1;
                    const float h[8] = {v0[0], v0[1], v0[2], v0[3], v1[0], v1[1], v1[2], v1[3]};
                    *(u32x4*)(hb + off) = pack8(h);
#pragma unroll
                    for (int i = 0; i < 8; ++i) ssq += h[i] * h[i];
                }
                ssq += __shfl_xor(ssq, 16); ssq += __shfl_xor(ssq, 32);
                if (fq == 0) atomicAdd(ss_out + row, ssq);
            }
    }
};
struct EpiProj {
    static constexpr bool PERM = true, AFTER_DRAIN = false;
    bf16_t* o1; int ld1; bf16_t* o2; int ld2; int split_pn; const float* ss;
    __device__ __forceinline__ void operator()(const f32x4 (&acc)[2][2][4][2], const Unit& u, int wr, int wc, int fr, int fq) const {
        const int row0 = u.pm * BM + wr * 64 + fr; const bool second = u.pn >= split_pn;
        bf16_t* dst = second ? o2 : o1; const int ld = second ? ld2 : ld1; const int colt = (second ? u.pn - split_pn : u.pn) * BM + wc * 32 + 8 * fq;
#pragma unroll
        for (int ai = 0; ai < 2; ++ai)
#pragma unroll
            for (int m = 0; m < 4; ++m) {
                const int row = row0 + ai * HALF + m * 16; const float rs = row_rstd(ss, row);
#pragma unroll
                for (int bj = 0; bj < 2; ++bj) {
                    float h[8];
#pragma unroll
                    for (int n = 0; n < 2; ++n)
#pragma unroll
                        for (int i = 0; i < 4; ++i) { const float v = acc[ai][bj][m][n][i] * rs; h[4 * n + i] = second ? fast_sigmoid(v) : v; }
                    *(u32x4*)(dst + (size_t)row * ld + colt + bj * HALF) = pack8(h);
                }
            }
    }
};
struct EpiMerge {
    static constexpr bool PERM = true, AFTER_DRAIN = false;
    const bf16_t* gates; bf16_t* tmp; bf16_t* merged;
    __device__ __forceinline__ void operator()(const f32x4 (&acc)[2][2][4][2], const Unit& u, int wr, int wc, int fr, int fq) const {
        const int row0 = u.pm * BM + wr * 64 + fr;
#pragma unroll
        for (int ai = 0; ai < 2; ++ai)
#pragma unroll
            for (int m = 0; m < 4; ++m) {
                const int row = row0 + ai * HALF + m * 16;
#pragma unroll
                for (int bj = 0; bj < 2; ++bj) {
                    const int col = u.pn * BM + bj * HALF + wc * 32 + 8 * fq;
                    const u32x4 gw = *(const u32x4*)(gates + (size_t)row * 2048 + u.z * 1024 + col);
                    const float gt[8] = {bf_lo(gw.x), bf_hi(gw.x), bf_lo(gw.y), bf_hi(gw.y), bf_lo(gw.z), bf_hi(gw.z), bf_lo(gw.w), bf_hi(gw.w)};
                    float h[8];
#pragma unroll
                    for (int n = 0; n < 2; ++n)
#pragma unroll
                        for (int i = 0; i < 4; ++i) h[4 * n + i] = acc[ai][bj][m][n][i] * gt[4 * n + i];
                    if (u.z) {
                        const u32x4 tw = *(const u32x4*)(tmp + (size_t)row * 1024 + col);
                        h[0] += bf_lo(tw.x); h[1] += bf_hi(tw.x); h[2] += bf_lo(tw.y); h[3] += bf_hi(tw.y); h[4] += bf_lo(tw.z); h[5] += bf_hi(tw.z); h[6] += bf_lo(tw.w); h[7] += bf_hi(tw.w);
                        *(u32x4*)(merged + (size_t)row * 1024 + col) = pack8(h);
                    } else *(u32x4*)(tmp + (size_t)row * 1024 + col) = pack8(h);
                }
            }
    }
};
struct MergeOrder : StaticOrder {
    __host__ __device__ bool next(int i, Unit& u) const { if (!StaticOrder::next(i >> 1, u)) return false; u.z = i & 1; return true; }
};

template <class Epi, class Sched, bool ALIGN_EPI = false, bool SP2 = false>
__device__ __forceinline__ void gemm_phase(PG8_LAS unsigned char* lds, const Gemm g, const Sched& S, const Epi& E) {
    const int tid = threadIdx.x, wid = __builtin_amdgcn_readfirstlane(tid >> 6), lane = tid & 63, wr = wid >> 2, wc = wid & 3, fr = lane & 15, fq = lane >> 4;
    const int K = g.K, nt = K / BK;
    unsigned voffA[2], voffB[2];
#pragma unroll
    for (int i = 0; i < 2; ++i) { int R, C; stage_rc(tid * 16 + i * 8192, R, C); const int Rb = Epi::PERM ? ((R & ~31) + perm32(R & 31)) : R;
        voffA[i] = (unsigned)(R * K + C) * 2u; voffB[i] = (unsigned)(Rb * K + C) * 2u; }
    const size_t kstep = (size_t)(BK * 2);
    const size_t hstep = (size_t)HALF * K * 2;
    const size_t tstep = 2 * hstep;
    const unsigned ldsw = (unsigned)wid * 1024u;
    const int aoff = lds_byte(wr * 64 + fr, fq * 8), boff = lds_byte(wc * 32 + fr, fq * 8);
#define PG8_SA(b, h) (((b) * 2 + (h)) * HTB)
#define PG8_SB(b, h) ((4 + (b) * 2 + (h)) * HTB)
#define PG8_STAGE(bufoff, gbase, voff) do { _Pragma("unroll") for (int _i = 0; _i < 2; ++_i) \
        __builtin_amdgcn_global_load_lds((const unsigned*)((const char*)(gbase) + (voff)[_i]), (PG8_LAS unsigned*)(lds + (bufoff) + ldsw + _i * 8192), 16, 0, 0); } while (0)
#define PG8_LDA(dst, b, h) do { _Pragma("unroll") for (int m = 0; m < 4; ++m) _Pragma("unroll") for (int k = 0; k < 2; ++k) dst[m][k] = *(const PG8_LAS bf16x8*)(lds + PG8_SA(b, h) + aoff + m * 2048 + k * 1024); } while (0)
#define PG8_LDB(dst, b, h) do { _Pragma("unroll") for (int n = 0; n < 2; ++n) _Pragma("unroll") for (int k = 0; k < 2; ++k) dst[n][k] = *(const PG8_LAS bf16x8*)(lds + PG8_SB(b, h) + boff + n * 2048 + k * 1024); } while (0)
#define PG8_MMA(ai, bj, At, Bt) do { __builtin_amdgcn_s_setprio(1); _Pragma("unroll") for (int m = 0; m < 4; ++m) _Pragma("unroll") for (int n = 0; n < 2; ++n) _Pragma("unroll") for (int k = 0; k < 2; ++k) \
        acc[ai][bj][m][n] = __builtin_amdgcn_mfma_f32_16x16x32_bf16(Bt[n][k], At[m][k], acc[ai][bj][m][n], 0, 0, 0); __builtin_amdgcn_s_setprio(0); } while (0)
#define PG8_WAIT_V(n) asm volatile("s_waitcnt vmcnt(" #n ")" ::: "memory")
#define PG8_WAIT_L(n) asm volatile("s_waitcnt lgkmcnt(" #n ")" ::: "memory")
#define PG8_BAR __builtin_amdgcn_s_barrier()
#define PG8_SCHED __builtin_amdgcn_sched_barrier(0)
    Unit cur, nxt; int ui = 0;
    if (!S.next(0, cur)) return;
    f32x4 acc[2][2][4][2];
#pragma unroll
    for (int a = 0; a < 2; ++a)
#pragma unroll
        for (int b = 0; b < 2; ++b)
#pragma unroll
            for (int m = 0; m < 4; ++m)
#pragma unroll
                for (int n = 0; n < 2; ++n) acc[a][b][m][n] = (f32x4){0.f, 0.f, 0.f, 0.f};
    bf16x8 At[4][2], B0[2][2], B1[2][2];
    const char* cA = (const char*)(cur.z ? g.A1 : g.A) + (size_t)cur.pm * tstep; const char* cB = (const char*)(cur.z ? g.Bt1 : g.Bt) + (size_t)cur.pn * tstep;
    S.a_ready(cur);
    if constexpr (SP2) {
        PG8_STAGE(PG8_SB(0, 0), cB, voffB); PG8_STAGE(PG8_SB(0, 1), cB + hstep, voffB); PG8_STAGE(PG8_SA(0, 0), cA, voffA); PG8_STAGE(PG8_SA(0, 1), cA + hstep, voffA);
        if (wr == 1) PG8_BAR;
        PG8_WAIT_V(2); PG8_BAR;
        PG8_STAGE(PG8_SB(1, 0), cB + kstep, voffB); PG8_STAGE(PG8_SA(1, 0), cA + kstep, voffA); PG8_STAGE(PG8_SB(1, 1), cB + hstep + kstep, voffB);
        PG8_WAIT_V(6); PG8_BAR;
    } else {
        PG8_STAGE(PG8_SB(0, 0), cB, voffB); PG8_STAGE(PG8_SA(0, 0), cA, voffA); PG8_STAGE(PG8_SB(0, 1), cB + hstep, voffB); PG8_STAGE(PG8_SA(0, 1), cA + hstep, voffA);
        if (wr == 1) PG8_BAR;
        PG8_WAIT_V(4); PG8_BAR;
        PG8_STAGE(PG8_SB(1, 0), cB + kstep, voffB); PG8_STAGE(PG8_SA(1, 0), cA + kstep, voffA); PG8_STAGE(PG8_SB(1, 1), cB + hstep + kstep, voffB);
        PG8_WAIT_V(6); PG8_BAR;
    }
    for (;;) {
        const bool has_next = S.next(ui + 1, nxt);
        const char* nA = has_next ? (const char*)(nxt.z ? g.A1 : g.A) + (size_t)nxt.pm * tstep : cA; const char* nB = has_next ? (const char*)(nxt.z ? g.Bt1 : g.Bt) + (size_t)nxt.pn * tstep : cB;
        for (int t = 0; t < nt; t += 2) {
            const bool last = (t == nt - 2);
            const char* a1 = cA + (size_t)(t + 1) * kstep;
            const char* a2 = last ? nA : cA + (size_t)(t + 2) * kstep; const char* b2 = last ? nB : cB + (size_t)(t + 2) * kstep;
            const char* a3 = a2 + kstep; const char* b3 = b2 + kstep;
            if (last && has_next) S.a_ready(nxt);
            if constexpr (SP2) {
            PG8_LDB(B0, 0, 0); PG8_LDB(B1, 0, 1); PG8_SCHED; PG8_LDA(At, 0, 0); PG8_STAGE(PG8_SA(1, 1), a1 + hstep, voffA);
            PG8_WAIT_V(8); PG8_WAIT_L(0); PG8_BAR; PG8_MMA(0, 0, At, B0); PG8_MMA(0, 1, At, B1); PG8_BAR; PG8_SCHED;
            PG8_LDA(At, 0, 1); PG8_STAGE(PG8_SB(0, 0), b2, voffB); PG8_STAGE(PG8_SB(0, 1), b2 + hstep, voffB); PG8_STAGE(PG8_SA(0, 0), a2, voffA);
            PG8_WAIT_V(8); PG8_WAIT_L(0); PG8_BAR; PG8_MMA(1, 0, At, B0); PG8_MMA(1, 1, At, B1); PG8_BAR; PG8_SCHED;
            PG8_LDB(B0, 1, 0); PG8_LDB(B1, 1, 1); PG8_SCHED; PG8_LDA(At, 1, 0); PG8_STAGE(PG8_SA(0, 1), a2 + hstep, voffA);
            PG8_WAIT_V(8); PG8_WAIT_L(0); PG8_BAR; PG8_MMA(0, 0, At, B0); PG8_MMA(0, 1, At, B1); PG8_BAR; PG8_SCHED;
            PG8_LDA(At, 1, 1); PG8_STAGE(PG8_SB(1, 0), b3, voffB); PG8_STAGE(PG8_SB(1, 1), b3 + hstep, voffB); PG8_STAGE(PG8_SA(1, 0), a3, voffA);
            PG8_WAIT_V(8); PG8_WAIT_L(0); PG8_BAR; PG8_MMA(1, 0, At, B0); PG8_MMA(1, 1, At, B1); PG8_BAR; PG8_SCHED;
            } else {
            PG8_LDB(B0, 0, 0); PG8_SCHED; PG8_LDA(At, 0, 0); PG8_STAGE(PG8_SA(1, 1), a1 + hstep, voffA);
            PG8_WAIT_L(8); PG8_BAR; PG8_WAIT_L(0); PG8_MMA(0, 0, At, B0); PG8_BAR; PG8_SCHED;
            PG8_LDB(B1, 0, 1); PG8_STAGE(PG8_SB(0, 0), b2, voffB);
            PG8_BAR; PG8_WAIT_L(0); PG8_MMA(0, 1, At, B1); PG8_BAR;
            PG8_LDA(At, 0, 1); PG8_STAGE(PG8_SA(0, 0), a2, voffA);
            PG8_BAR; PG8_WAIT_L(0); PG8_MMA(1, 0, At, B0); PG8_BAR; PG8_SCHED;
            PG8_STAGE(PG8_SB(0, 1), b2 + hstep, voffB);
            PG8_WAIT_V(6); PG8_BAR; PG8_MMA(1, 1, At, B1); PG8_BAR;
            PG8_LDB(B0, 1, 0); PG8_SCHED; PG8_LDA(At, 1, 0); PG8_STAGE(PG8_SA(0, 1), a2 + hstep, voffA);
            PG8_WAIT_L(8); PG8_BAR; PG8_WAIT_L(0); PG8_MMA(0, 0, At, B0); PG8_BAR; PG8_SCHED;
            PG8_LDB(B1, 1, 1); PG8_STAGE(PG8_SB(1, 0), b3, voffB);
            PG8_BAR; PG8_WAIT_L(0); PG8_MMA(0, 1, At, B1); PG8_BAR;
            PG8_LDA(At, 1, 1); PG8_STAGE(PG8_SA(1, 0), a3, voffA);
            PG8_BAR; PG8_WAIT_L(0); PG8_MMA(1, 0, At, B0); PG8_BAR; PG8_SCHED;
            PG8_STAGE(PG8_SB(1, 1), b3 + hstep, voffB);
            PG8_WAIT_V(6); PG8_BAR; PG8_MMA(1, 1, At, B1); PG8_BAR;
            }
        }
        if constexpr (ALIGN_EPI) { if (wr == 0) PG8_BAR; }
        if constexpr (!Epi::AFTER_DRAIN) { E(acc, cur, wr, wc, fr, fq); S.done(cur); }
        if (!has_next) break;
#pragma unroll
        for (int a = 0; a < 2; ++a)
#pragma unroll
            for (int b = 0; b < 2; ++b)
#pragma unroll
                for (int m = 0; m < 4; ++m)
#pragma unroll
                    for (int n = 0; n < 2; ++n) acc[a][b][m][n] = (f32x4){0.f, 0.f, 0.f, 0.f};
        cur = nxt; cA = nA; cB = nB; ++ui;
        if constexpr (ALIGN_EPI) { if (wr == 1) PG8_BAR; }
    }
    PG8_WAIT_V(0);
    if constexpr (!ALIGN_EPI) { if (wr == 0) PG8_BAR; }
    PG8_BAR;
    if constexpr (Epi::AFTER_DRAIN) { E.fused(acc, cur, wr, wc, fr, fq, lds, wid, lane); S.done(cur); }
#undef PG8_SA
#undef PG8_SB
#undef PG8_STAGE
#undef PG8_LDA
#undef PG8_LDB
#undef PG8_MMA
#undef PG8_WAIT_V
#undef PG8_WAIT_L
#undef PG8_BAR
#undef PG8_SCHED
}
}

#define GAS __attribute__((address_space(1)))
#define LAS __attribute__((address_space(3)))
typedef unsigned short bf16;
typedef unsigned v4u __attribute__((ext_vector_type(4)));
typedef float f32x4 __attribute__((ext_vector_type(4)));
typedef short bf16x8 __attribute__((ext_vector_type(8)));
typedef GAS unsigned gu32;
typedef GAS unsigned long long gu64;
#define RLX_AGENT __ATOMIC_RELAXED, __HIP_MEMORY_SCOPE_AGENT
#define LDS_WAIT() asm volatile("s_waitcnt lgkmcnt(0)" ::: "memory")
#define VM_WAIT() asm volatile("s_waitcnt vmcnt(0)" ::: "memory")
__device__ __forceinline__ unsigned long long rt() { return __builtin_amdgcn_s_memrealtime(); }
__device__ __forceinline__ unsigned f2bf(float f) { unsigned u = __builtin_bit_cast(unsigned, f); return (u + 0x7fffu + ((u >> 16) & 1u)) >> 16; }
__device__ __forceinline__ unsigned pk2(float lo, float hi) { return f2bf(lo) | (f2bf(hi) << 16); }
#define XB_TMO      128
#define XB_XCNT(j)  (256  + 64 * (j))
#define XB_XSUB(j)  (1280 + 64 * (j))
#define XB_XGEN(j)  (2304 + 64 * (j))
#define XB_TOP      3328
#define XB_TOPGEN   3392
#define XCD_BAR_WORDS 3456
#define XB_SPIN_CAP (1u << 18)

__device__ __forceinline__ unsigned xb_ld(unsigned* p)              { return __hip_atomic_load(p, __ATOMIC_RELAXED, __HIP_MEMORY_SCOPE_AGENT); }
__device__ __forceinline__ unsigned xb_add(unsigned* p, unsigned v) { return __hip_atomic_fetch_add(p, v, __ATOMIC_RELAXED, __HIP_MEMORY_SCOPE_AGENT); }
__device__ __forceinline__ unsigned xb_xcc_id() { return (unsigned)__builtin_amdgcn_s_getreg((3 << 11) | 20) & 0xFu; }
#define XB_SPIN(cond, bar) do { unsigned _sp = 0; while (cond) { __builtin_amdgcn_s_sleep(1); \
    if ((++_sp & 255u) == 0u) { if (xb_ld(&(bar)[XB_TMO])) break; if (_sp > XB_SPIN_CAP) { atomicAdd(&(bar)[XB_TMO], 1u); break; } } } } while (0)

struct XcdBarrier {
    unsigned* bar; unsigned x;
    volatile LAS unsigned* st;
};

__device__ __forceinline__ XcdBarrier xcd_barrier_post(unsigned* bar, volatile LAS unsigned* st) {
    XcdBarrier b; b.bar = bar; b.x = xb_xcc_id(); b.st = st;
    if (threadIdx.x == 0) (void)xb_add(&bar[XB_XCNT(b.x)], 1u);
    return b;
}
__device__ __forceinline__ void xcd_barrier_complete(unsigned* bar, unsigned x, unsigned& nloc, unsigned& nx) {
    const unsigned G = gridDim.x * gridDim.y * gridDim.z;
    unsigned sum, cnt, mine, sp = 0u;
    for (;;) {
        sum = 0u; cnt = 0u; mine = 0u;
#pragma unroll
        for (unsigned j = 0; j < 16; ++j) { const unsigned c = xb_ld(&bar[XB_XCNT(j)]); sum += c; cnt += (c > 0u) ? 1u : 0u; mine = (j == x) ? c : mine; }
        if (sum == G) break;
        __builtin_amdgcn_s_sleep(1);
        if ((++sp & 255u) == 0u) { if (xb_ld(&bar[XB_TMO])) break; if (sp > XB_SPIN_CAP) { atomicAdd(&bar[XB_TMO], 1u); break; } }
    }
    nloc = mine > 0u ? mine : 1u; nx = cnt > 0u ? cnt : 1u;
}

__device__ __forceinline__ void xcd_barrier(const XcdBarrier& b) {
    asm volatile("s_waitcnt vmcnt(0)" ::: "memory");
    __syncthreads();
    if (threadIdx.x == 0) {
        unsigned* bar = b.bar;
        __builtin_amdgcn_s_waitcnt(0);
        unsigned nloc = b.st[0], nx = b.st[1];
        if (nloc == 0u) { xcd_barrier_complete(bar, b.x, nloc, nx); b.st[0] = nloc; b.st[1] = nx; }
        const unsigned old = xb_add(&bar[XB_XSUB(b.x)], 1u);
        const unsigned gen = old / nloc;
        if (old + 1u == (gen + 1u) * nloc) {
            __builtin_amdgcn_fence(__ATOMIC_RELEASE, "agent");
            asm volatile("s_waitcnt vmcnt(0)" ::: "memory");
            const unsigned og = xb_add(&bar[XB_TOP], 1u);
            const unsigned tg = og / nx;
            if (og + 1u == (tg + 1u) * nx) xb_add(&bar[XB_TOPGEN], 1u);
            else XB_SPIN(xb_ld(&bar[XB_TOPGEN]) == tg, bar);
            __builtin_amdgcn_fence(__ATOMIC_ACQUIRE, "agent");
            xb_add(&bar[XB_XGEN(b.x)], 1u);
            asm volatile("s_waitcnt vmcnt(0)" ::: "memory");
        } else {
            XB_SPIN(xb_ld(&bar[XB_XGEN(b.x)]) == gen, bar);
            __builtin_amdgcn_fence(__ATOMIC_ACQUIRE, "agent");
            asm volatile("s_waitcnt vmcnt(0)" ::: "memory");
        }
    }
    __syncthreads();
}

constexpr int NWAVES = 8;
#ifndef ATTN_NAIVE
#define ATTN_NAIVE 0
#endif
#ifndef MK_N_LAUNCHES
#define MK_N_LAUNCHES 1
#endif
constexpr int N_PHASES = 12;
constexpr int N_LAUNCHES = MK_N_LAUNCHES;

constexpr int M = 16384, SEQ = 2048, D = 1024, FF = 2816, NGU = 2 * FF, NIN = 8704, NATT = 4608, NHG = 2048, NGATE = 2048;
constexpr float EPS = 1e-6f;

constexpr size_t MiB = 1u << 20;
constexpr size_t WS_CTL = 0, CTL_ZERO_BYTES = 1 * MiB;
constexpr size_t WS_SS = 1 * MiB;
constexpr size_t WS_WGU1 = 2 * MiB, WS_WD1 = 13 * MiB, WS_WGU2 = 18 * MiB + 512 * 1024, WS_WD2 = 29 * MiB + 512 * 1024, WS_WIN = 35 * MiB, WS_WA = 52 * MiB, WS_WB = 53 * MiB, WS_WO = 54 * MiB;
constexpr size_t WS_HB = 56 * MiB;
constexpr size_t WS_BIG = 88 * MiB;
constexpr size_t WS_HID = WS_BIG;
constexpr size_t WS_AQKV = WS_BIG, WS_YB = 232 * MiB;
constexpr size_t WS_HQ = WS_BIG, WS_GATES = 152 * MiB, WS_YA = 216 * MiB;
constexpr size_t WS_TMP = WS_BIG, WS_MERGED = 120 * MiB;
constexpr size_t WS_O2S = 2 * MiB, WS_LSE = 248 * MiB;
constexpr size_t WS_END = 256 * MiB;
static_assert(WS_WGU1 + (size_t)NGU * D * 2 <= WS_WD1 && WS_WD1 + (size_t)D * FF * 2 <= WS_WGU2 && WS_WGU2 + (size_t)NGU * D * 2 <= WS_WD2 && WS_WD2 + (size_t)D * FF * 2 <= WS_WIN && WS_WIN + (size_t)NIN * D * 2 <= WS_WA, "ws map: weights");
static_assert(WS_HB + (size_t)M * D * 2 <= WS_BIG && WS_HID + (size_t)M * FF * 2 <= WS_END && WS_AQKV + (size_t)M * NATT * 2 <= WS_YB && WS_YB + (size_t)M * 512 * 2 <= WS_END, "ws map: acts");
static_assert(WS_HQ + (size_t)M * NHG * 2 <= WS_GATES && WS_GATES + (size_t)M * NGATE * 2 <= WS_YA && WS_YA + (size_t)M * 512 * 2 <= WS_YB && WS_TMP + (size_t)M * D * 2 <= WS_MERGED && WS_MERGED + (size_t)M * D * 2 <= WS_GATES, "ws map: mixer");
constexpr int CW_BAR = 4096;

constexpr int RING_OFF = 0, RING_BYTES = 131072;
constexpr int LDSCTL_OFF = RING_BYTES, MISC_OFF = LDSCTL_OFF + 320;
constexpr int LDS_BYTES = 147456;

__device__ __forceinline__ float bf2f(bf16 x) { return __uint_as_float((unsigned)x << 16); }
__device__ __forceinline__ float wave_sum(float v) {
#pragma unroll
    for (int o = 1; o < 64; o <<= 1) v += __shfl_xor(v, o);
    return v;
}
__device__ __forceinline__ float wave_max(float v) {
#pragma unroll
    for (int o = 1; o < 64; o <<= 1) v = fmaxf(v, __shfl_xor(v, o));
    return v;
}
__device__ __forceinline__ float sigmoidf_(float x) { return 1.0f / (1.0f + __expf(-x)); }

__device__ __forceinline__ void p0_transpose_item(const float* W, const float* gain, int K, int N, bf16* WT, int mapmode, LAS float* scr, int item, int lane) {
    const int nblk = N / 32, kb = item / nblk, nb = item % nblk, k0 = 64 * kb, n0 = 32 * nb;
    int d0;
    if (mapmode == 1) { const int bj = n0 >= FF ? 1 : 0, c = n0 - bj * FF; d0 = (c >> 7) * 256 + bj * 128 + (c & 127); }
    else if (mapmode == 2) { d0 = n0 < 2048 ? n0 : (n0 < 6656 ? 4096 + (n0 - 2048) : 2048 + (n0 - 6656)); }
    else d0 = n0;
#pragma unroll 8
    for (int i = 0; i < 32; ++i) { const int kk = 2 * i + (lane >> 5); const float g = gain ? gain[k0 + kk] : 1.0f; scr[kk * 33 + (lane & 31)] = W[(size_t)(k0 + kk) * N + n0 + (lane & 31)] * g; }
    LDS_WAIT(); asm volatile("" ::: "memory");
    const int c = lane & 7;
#pragma unroll
    for (int j = 0; j < 4; ++j) { const int n = (lane >> 3) + 8 * j; const LAS float* s = scr + (8 * c) * 33 + n;
        v4u o; o.x = pk2(s[0 * 33], s[1 * 33]); o.y = pk2(s[2 * 33], s[3 * 33]); o.z = pk2(s[4 * 33], s[5 * 33]); o.w = pk2(s[6 * 33], s[7 * 33]);
        *(GAS v4u*)(WT + (size_t)(d0 + n) * K + k0 + 8 * c) = o; }
    LDS_WAIT(); asm volatile("" ::: "memory");
}

__device__ __forceinline__ void hgrn_naive(const bf16* HQ, const float* lbraw, const float* onorm, bf16* YA, LAS unsigned char* lds, int tid) {
    if (blockIdx.x >= 16) return;
    constexpr int TB = 8;
    LAS f32x4* L4 = (LAS f32x4*)lds;
    LAS float* OB = (LAS float*)(lds + 2 * TB * 128 * 16);
    LAS float* WSUM = OB + 2 * TB * 2 * 128;
    const int cw = tid >> 8, kh = (tid >> 7) & 1, v = tid & 127, lane = tid & 63, wv = (tid >> 6) & 1;
    const int chain = blockIdx.x * 2 + cw, b = chain >> 2, h = chain & 3;
    const float a0 = lbraw[h * 128 + v], a1 = lbraw[512 + h * 128 + v];
    const float lb = 1.0f / (1.0f + __expf(a1 - a0));
    const float gain = onorm[h * 128 + v];
    float S[64];
#pragma unroll
    for (int k = 0; k < 64; ++k) S[k] = 0.f;
    for (int t0 = 0; t0 < SEQ; t0 += TB) {
#pragma unroll 1
        for (int tt = kh; tt < TB; tt += 2) {
            const size_t row = (size_t)b * SEQ + t0 + tt;
            const float qv = bf2f(HQ[row * 2048 + h * 128 + v]), fp = bf2f(HQ[row * 2048 + 512 + h * 128 + v]);
            const float f = lb + (1.0f - lb) * sigmoidf_(fp);
            L4[(cw * TB + tt) * 128 + v] = (f32x4){qv, f, 1.0f - f, 0.f};
        }
        __syncthreads();
#pragma unroll 1
        for (int tt = 0; tt < TB; ++tt) {
            const size_t row = (size_t)b * SEQ + t0 + tt;
            const float iv = bf2f(HQ[row * 2048 + 1024 + h * 128 + v]);
            float ot = 0.f;
#pragma unroll
            for (int kg = 0; kg < 8; ++kg) {
#pragma unroll
                for (int k8 = 0; k8 < 8; ++k8) { const int k = kg * 8 + k8; const f32x4 e = L4[(cw * TB + tt) * 128 + kh * 64 + k]; S[k] = e[1] * S[k] + e[2] * iv; ot += e[0] * S[k]; }
                __builtin_amdgcn_sched_barrier(0);
            }
            OB[((cw * TB + tt) * 2 + kh) * 128 + v] = ot;
        }
        __syncthreads();
        float o4[4];
#pragma unroll
        for (int i = 0; i < 4; ++i) {
            const int tt = 2 * i + kh;
            o4[i] = OB[((cw * TB + tt) * 2 + 0) * 128 + v] + OB[((cw * TB + tt) * 2 + 1) * 128 + v];
            const float sq = wave_sum(o4[i] * o4[i]);
            if (lane == 0) WSUM[(cw * TB + tt) * 2 + wv] = sq;
        }
        __syncthreads();
#pragma unroll
        for (int i = 0; i < 4; ++i) {
            const int tt = 2 * i + kh;
            const size_t row = (size_t)b * SEQ + t0 + tt;
            const float tot = WSUM[(cw * TB + tt) * 2] + WSUM[(cw * TB + tt) * 2 + 1];
            const float rs = rsqrtf(tot * (1.0f / 128.0f) + EPS);
            const float og = bf2f(HQ[row * 2048 + 1536 + h * 128 + v]);
            const float y = o4[i] * rs * gain * (og * sigmoidf_(og));
            YA[row * 512 + h * 128 + v] = (bf16)f2bf(y);
        }
        __syncthreads();
    }
}

__device__ __forceinline__ void attn_naive(const bf16* AQKV, bf16* YB, LAS float* wq, int gw, int NGW, int lane) {
    for (int unit = gw; unit < M * 8; unit += NGW) {
        const int row = unit >> 3, hs = unit & 7, b = row >> 11, s = row & (SEQ - 1);
        float m_run = -1e30f, l_run = 0.f, acc = 0.f;
#pragma unroll 1
        for (int g = 0; g < 3; ++g) {
            const int d = g == 0 ? 1 : (g == 1 ? 4 : 16);
            const float slope = exp2f(-8.0f * (float)(g * 8 + hs + 1) / 24.0f);
            const int qcol = g * 1536 + hs * 64, kcol = qcol + 512, vcol = qcol + 1024;
            wq[lane] = bf2f(AQKV[(size_t)row * NATT + qcol + lane]) * 0.125f;
            const int lq = s / d, nk = (lq < 128 ? lq : 128) + 1;
#pragma unroll 1
            for (int c0 = 0; c0 < nk; c0 += 64) {
                const int j = c0 + lane; const bool valid = j < nk;
                float sc = -1e30f;
                if (valid) {
                    const bf16* kr = AQKV + (size_t)(b * SEQ + s - j * d) * NATT + kcol;
                    float dot = 0.f;
#pragma unroll
                    for (int e8 = 0; e8 < 8; ++e8) {
                        const v4u w = *(const v4u*)(kr + e8 * 8);
                        dot += wq[e8 * 8 + 0] * __uint_as_float(w.x << 16) + wq[e8 * 8 + 1] * __uint_as_float(w.x & 0xffff0000u)
                             + wq[e8 * 8 + 2] * __uint_as_float(w.y << 16) + wq[e8 * 8 + 3] * __uint_as_float(w.y & 0xffff0000u)
                             + wq[e8 * 8 + 4] * __uint_as_float(w.z << 16) + wq[e8 * 8 + 5] * __uint_as_float(w.z & 0xffff0000u)
                             + wq[e8 * 8 + 6] * __uint_as_float(w.w << 16) + wq[e8 * 8 + 7] * __uint_as_float(w.w & 0xffff0000u);
                    }
                    sc = dot - slope * (float)(d * j);
                }
                const float m_new = fmaxf(m_run, wave_max(sc));
                const float p = valid ? __expf(sc - m_new) : 0.f;
                const float corr = __expf(m_run - m_new);
                l_run = l_run * corr + wave_sum(p); acc *= corr; m_run = m_new;
                const int cnt = (nk - c0) < 64 ? (nk - c0) : 64;
#pragma unroll 1
                for (int jj = 0; jj < cnt; ++jj) {
                    const float pj = __uint_as_float(__builtin_amdgcn_readlane(__float_as_uint(p), jj));
                    acc += pj * bf2f(AQKV[(size_t)(b * SEQ + s - (c0 + jj) * d) * NATT + vcol + lane]);
                }
            }
        }
        YB[(size_t)row * 512 + hs * 64 + lane] = (bf16)f2bf(acc / l_run);
    }
}

typedef float f32x16 __attribute__((ext_vector_type(16)));
typedef short s16x4 __attribute__((ext_vector_type(4)));
typedef short v4i16_t __attribute__((ext_vector_type(4)));
typedef unsigned v2u __attribute__((ext_vector_type(2)));
__device__ __forceinline__ s16x4 lds_tr(const LAS unsigned char* p) { return __builtin_bit_cast(s16x4, __builtin_amdgcn_ds_read_tr16_b64_v4i16((LAS v4i16_t*)p)); }
__device__ __forceinline__ unsigned cvtpk(float lo, float hi) { unsigned r; asm volatile("v_cvt_pk_bf16_f32 %0, %1, %2" : "=v"(r) : "v"(lo), "v"(hi)); return r; }

__device__ __forceinline__ void attn_tile(const bf16* AQKV, int b, int hs, int g, int d, int res, int l0, LAS unsigned char* vst, int lane,
                                          f32x16& o0, f32x16& o1, float& m_run, float& l_run) {
    const int r32 = lane & 31, hi = lane >> 5;
    const int qcol = g * 1536 + hs * 64, kcol = qcol + 512, vcol = qcol + 1024;
    const float slope = exp2f(-8.0f * (float)(g * 8 + hs + 1) / 24.0f);
    const float c1 = 0.125f * 1.4426950408889634f, c2 = slope * (float)d * 1.4426950408889634f;
    const size_t qrow = (size_t)b * SEQ + (size_t)(l0 + r32) * d + res;
    bf16x8 qf[4];
#pragma unroll
    for (int kk = 0; kk < 4; ++kk) qf[kk] = *(const bf16x8*)(AQKV + qrow * NATT + qcol + kk * 16 + hi * 8);
#pragma unroll
    for (int r = 0; r < 16; ++r) { o0[r] = 0.f; o1[r] = 0.f; }
    m_run = -1e30f; l_run = 0.f;
    const int lq = l0 + r32;
#pragma unroll 1
    for (int kt = 0; kt < 5; ++kt) {
        const int k0 = l0 - 128 + 32 * kt;
        if (k0 < 0) continue;
        const size_t krow = (size_t)b * SEQ + (size_t)(k0 + r32) * d + res;
        bf16x8 kf[4];
#pragma unroll
        for (int kk = 0; kk < 4; ++kk) kf[kk] = *(const bf16x8*)(AQKV + krow * NATT + kcol + kk * 16 + hi * 8);
#pragma unroll
        for (int i = 0; i < 4; ++i) {
            const int key = (lane >> 3) + 8 * i, cc = lane & 7;
            const size_t vrow = (size_t)b * SEQ + (size_t)(k0 + key) * d + res;
            const v4u w = *(const v4u*)(AQKV + vrow * NATT + vcol + cc * 8);
            *(LAS v4u*)(vst + (cc >> 2) * 2048 + key * 64 + (cc & 3) * 16) = w;
        }
        f32x16 s;
#pragma unroll
        for (int r = 0; r < 16; ++r) s[r] = 0.f;
#pragma unroll
        for (int kk = 0; kk < 4; ++kk) s = __builtin_amdgcn_mfma_f32_32x32x16_bf16(kf[kk], qf[kk], s, 0, 0, 0);
        float tmax = -1e30f;
#pragma unroll
        for (int r = 0; r < 16; ++r) {
            const int keyi = (r & 3) + 8 * (r >> 2) + 4 * hi;
            const int delta = lq - (k0 + keyi);
            const float t = s[r] * c1 - c2 * (float)delta;
            s[r] = (delta >= 0 && delta <= 128) ? t : -1e30f;
            tmax = fmaxf(tmax, s[r]);
        }
        tmax = fmaxf(tmax, __shfl_xor(tmax, 32));
        const float m_new = fmaxf(m_run, tmax);
        const float corr = __builtin_amdgcn_exp2f(m_run - m_new);
        float psum = 0.f;
#pragma unroll
        for (int r = 0; r < 16; ++r) { s[r] = __builtin_amdgcn_exp2f(s[r] - m_new); psum += s[r]; }
        psum += __shfl_xor(psum, 32);
        l_run = l_run * corr + psum; m_run = m_new;
#pragma unroll
        for (int r = 0; r < 16; ++r) { o0[r] *= corr; o1[r] *= corr; }
        bf16x8 pf[2];
#pragma unroll
        for (int si = 0; si < 2; ++si) {
            v4u w; w.x = cvtpk(s[8 * si + 0], s[8 * si + 1]); w.y = cvtpk(s[8 * si + 2], s[8 * si + 3]); w.z = cvtpk(s[8 * si + 4], s[8 * si + 5]); w.w = cvtpk(s[8 * si + 6], s[8 * si + 7]);
            pf[si] = __builtin_bit_cast(bf16x8, w);
        }
#pragma unroll
        for (int si = 0; si < 2; ++si) {
            const LAS unsigned char* vb = vst + (16 * si + 4 * hi + ((lane & 15) >> 2)) * 64 + ((lane >> 4) & 1) * 32 + (lane & 3) * 8;
            const s16x4 a0 = lds_tr(vb), a1 = lds_tr(vb + 512), b0 = lds_tr(vb + 2048), b1 = lds_tr(vb + 2048 + 512);
            const bf16x8 vf0 = (bf16x8){a0[0], a0[1], a0[2], a0[3], a1[0], a1[1], a1[2], a1[3]};
            const bf16x8 vf1 = (bf16x8){b0[0], b0[1], b0[2], b0[3], b1[0], b1[1], b1[2], b1[3]};
            o0 = __builtin_amdgcn_mfma_f32_32x32x16_bf16(vf0, pf[si], o0, 0, 0, 0);
            o1 = __builtin_amdgcn_mfma_f32_32x32x16_bf16(vf1, pf[si], o1, 0, 0, 0);
        }
    }
}

__device__ __forceinline__ void attn_phase(const bf16* AQKV, bf16* YB, bf16* O2S, float* LSE, LAS unsigned char* lds, int vcu, int G, int wave, int lane) {
    LAS unsigned char* vst = lds + wave * 4096;
    const int r32 = lane & 31, hi = lane >> 5;
    for (int u = vcu; u < 256; u += G) {
        const int b = u >> 5, hs = (u >> 2) & 7, P0 = (u & 3) * 512;
#pragma unroll 1
        for (int i = 0; i < 4; ++i) {
            const int ta = wave + 8 * i, g = ta >> 4, ti = ta & 15;
            const int d = g == 0 ? 1 : 4, tpr = 16 / d, res = ti / tpr, l0 = P0 / d + 32 * (ti % tpr);
            f32x16 o0, o1; float m_run, l_run;
            attn_tile(AQKV, b, hs, g, d, res, l0, vst, lane, o0, o1, m_run, l_run);
            const size_t row = (size_t)b * SEQ + (size_t)(l0 + r32) * d + res;
            const float inv = 1.0f / l_run;
            bf16* dst = (g == 0 ? YB : O2S) + row * 512 + hs * 64 + 4 * hi;
#pragma unroll
            for (int q = 0; q < 4; ++q) {
                v2u w0; w0.x = cvtpk(o0[4 * q] * inv, o0[4 * q + 1] * inv); w0.y = cvtpk(o0[4 * q + 2] * inv, o0[4 * q + 3] * inv);
                v2u w1; w1.x = cvtpk(o1[4 * q] * inv, o1[4 * q + 1] * inv); w1.y = cvtpk(o1[4 * q + 2] * inv, o1[4 * q + 3] * inv);
                *(v2u*)(dst + 8 * q) = w0; *(v2u*)(dst + 32 + 8 * q) = w1;
            }
            if (hi == 0) LSE[(size_t)g * (M * 8) + row * 8 + hs] = m_run + __log2f(l_run);
        }
        asm volatile("s_waitcnt vmcnt(0)" ::: "memory");
        __syncthreads();
#pragma unroll 1
        for (int i = 0; i < 2; ++i) {
            const int res = wave + 8 * i, l0 = P0 / 16;
            f32x16 o0, o1; float m_run, l_run;
            attn_tile(AQKV, b, hs, 2, 16, res, l0, vst, lane, o0, o1, m_run, l_run);
            const size_t row = (size_t)b * SEQ + (size_t)(l0 + r32) * 16 + res;
            const float e3 = m_run + __log2f(l_run);
            const float e1 = __uint_as_float(__hip_atomic_load((const unsigned*)(LSE + row * 8 + hs), RLX_AGENT));
            const float e2 = __uint_as_float(__hip_atomic_load((const unsigned*)(LSE + (size_t)(M * 8) + row * 8 + hs), RLX_AGENT));
            const float mx = fmaxf(fmaxf(e1, e2), e3);
            const float w1 = __builtin_amdgcn_exp2f(e1 - mx), w2 = __builtin_amdgcn_exp2f(e2 - mx), w3 = __builtin_amdgcn_exp2f(e3 - mx);
            const float iw = 1.0f / (w1 + w2 + w3);
            const float a1 = w1 * iw, a2 = w2 * iw, a3 = w3 * iw / l_run;
            const size_t off = row * 512 + hs * 64 + 4 * hi;
#pragma unroll
            for (int q = 0; q < 4; ++q) {
#pragma unroll
                for (int dh = 0; dh < 2; ++dh) {
                    const unsigned long long x1 = __hip_atomic_load((const unsigned long long*)(YB + off + 32 * dh + 8 * q), RLX_AGENT);
                    const unsigned long long x2 = __hip_atomic_load((const unsigned long long*)(O2S + off + 32 * dh + 8 * q), RLX_AGENT);
                    const unsigned x1l = (unsigned)x1, x1h = (unsigned)(x1 >> 32), x2l = (unsigned)x2, x2h = (unsigned)(x2 >> 32);
                    const float v0 = (dh ? o1[4 * q] : o0[4 * q]), v1 = (dh ? o1[4 * q + 1] : o0[4 * q + 1]), v2 = (dh ? o1[4 * q + 2] : o0[4 * q + 2]), v3 = (dh ? o1[4 * q + 3] : o0[4 * q + 3]);
                    const float y0 = a1 * __uint_as_float(x1l << 16) + a2 * __uint_as_float(x2l << 16) + a3 * v0;
                    const float y1 = a1 * __uint_as_float(x1l & 0xffff0000u) + a2 * __uint_as_float(x2l & 0xffff0000u) + a3 * v1;
                    const float y2 = a1 * __uint_as_float(x1h << 16) + a2 * __uint_as_float(x2h << 16) + a3 * v2;
                    const float y3 = a1 * __uint_as_float(x1h & 0xffff0000u) + a2 * __uint_as_float(x2h & 0xffff0000u) + a3 * v3;
                    v2u w; w.x = cvtpk(y0, y1); w.y = cvtpk(y2, y3);
                    *(v2u*)(YB + off + 32 * dh + 8 * q) = w;
                }
            }
        }
        asm volatile("s_waitcnt vmcnt(0)" ::: "memory");
        __syncthreads();
    }
}

struct Args { const float* in[15]; float* out; unsigned char* ws; int ph_lo, ph_hi, li, pad; };
__global__ void __launch_bounds__(NWAVES * 64, 2) mk_fwd(Args args) {
    __shared__ __attribute__((aligned(16))) unsigned char lds_raw[LDS_BYTES];
    LAS unsigned char* lds = (LAS unsigned char*)lds_raw;
    volatile LAS unsigned* MISC = (volatile LAS unsigned*)(lds + MISC_OFF);
    const int tid = threadIdx.x, lane = tid & 63, wave = __builtin_amdgcn_readfirstlane(tid >> 6);
    const int G = gridDim.x; const int bx = blockIdx.x; const int vcu = (G % 8 == 0) ? (bx % 8) * (G / 8) + bx / 8 : bx;
    const int gw = vcu * NWAVES + wave, NGW = G * NWAVES;
    unsigned char* ws = args.ws;
    gu32* ctl = (gu32*)(ws + WS_CTL);
    const float* x = args.in[0]; const float* ffn1_norm = args.in[1]; const float* ffn1_wgu = args.in[2]; const float* ffn1_wd = args.in[3]; const float* mix_norm = args.in[4];
    const float* w_in = args.in[5]; const float* hg_lb = args.in[6]; const float* hg_onorm = args.in[7]; const float* w_bhg = args.in[8]; const float* w_batt = args.in[9];
    const float* w_out = args.in[10]; const float* ffn2_norm = args.in[11]; const float* ffn2_wgu = args.in[12]; const float* ffn2_wd = args.in[13]; const float* final_norm = args.in[14];
    float* out = args.out;
    float* SS = (float*)(ws + WS_SS);
    bf16* WGU1 = (bf16*)(ws + WS_WGU1); bf16* WD1 = (bf16*)(ws + WS_WD1); bf16* WGU2 = (bf16*)(ws + WS_WGU2); bf16* WD2 = (bf16*)(ws + WS_WD2);
    bf16* WIN = (bf16*)(ws + WS_WIN); bf16* WA = (bf16*)(ws + WS_WA); bf16* WB = (bf16*)(ws + WS_WB); bf16* WO = (bf16*)(ws + WS_WO);
    bf16* HB = (bf16*)(ws + WS_HB); bf16* HID = (bf16*)(ws + WS_HID); bf16* AQKV = (bf16*)(ws + WS_AQKV); bf16* YB = (bf16*)(ws + WS_YB);
    bf16* HQ = (bf16*)(ws + WS_HQ); bf16* GATES = (bf16*)(ws + WS_GATES); bf16* YA = (bf16*)(ws + WS_YA); bf16* TMP = (bf16*)(ws + WS_TMP); bf16* MERGED = (bf16*)(ws + WS_MERGED);

    for (int u = tid; u < (LDS_BYTES - LDSCTL_OFF) / 4; u += NWAVES * 64) ((LAS unsigned*)(lds + LDSCTL_OFF))[u] = 0u;
    __syncthreads();
    XcdBarrier bar; bar.bar = (unsigned*)(ctl + CW_BAR); bar.x = 0; bar.st = nullptr;
    if (N_LAUNCHES == 1) bar = xcd_barrier_post((unsigned*)(ctl + CW_BAR), MISC + 8);
    const int lo = args.ph_lo, hi = args.ph_hi;
#define IN(k) (lo <= (k) && (k) < hi)
#define SEAM(k) do { if (IN(k) && IN((k) + 1)) xcd_barrier(bar); } while (0)

    if (IN(0)) {
        LAS float* scr = (LAS float*)(lds + RING_OFF + wave * 16384);
        constexpr int I_GU = (D / 64) * (NGU / 32), I_DN = (FF / 64) * (D / 32), I_IN = (D / 64) * (NIN / 32), I_BR = (512 / 64) * (D / 32), I_WO = (D / 64) * (D / 32);
        constexpr int NITEMS = 2 * I_GU + 2 * I_DN + I_IN + 2 * I_BR + I_WO;
        for (int it = gw; it < NITEMS; it += NGW) {
            int r = it;
            if (r < I_GU) { p0_transpose_item(ffn1_wgu, ffn1_norm, D, NGU, WGU1, 1, scr, r, lane); continue; } r -= I_GU;
            if (r < I_GU) { p0_transpose_item(ffn2_wgu, ffn2_norm, D, NGU, WGU2, 1, scr, r, lane); continue; } r -= I_GU;
            if (r < I_DN) { p0_transpose_item(ffn1_wd, nullptr, FF, D, WD1, 0, scr, r, lane); continue; } r -= I_DN;
            if (r < I_DN) { p0_transpose_item(ffn2_wd, nullptr, FF, D, WD2, 0, scr, r, lane); continue; } r -= I_DN;
            if (r < I_IN) { p0_transpose_item(w_in, mix_norm, D, NIN, WIN, 2, scr, r, lane); continue; } r -= I_IN;
            if (r < I_BR) { p0_transpose_item(w_bhg, nullptr, 512, D, WA, 0, scr, r, lane); continue; } r -= I_BR;
            if (r < I_BR) { p0_transpose_item(w_batt, nullptr, 512, D, WB, 0, scr, r, lane); continue; } r -= I_BR;
            p0_transpose_item(w_out, nullptr, D, D, WO, 0, scr, r, lane);
        }
        for (int m = gw; m < M; m += NGW) {
            const GAS f32x4* xr = (const GAS f32x4*)(x + (size_t)m * D) + lane;
            f32x4 v[4]; float s = 0.f;
#pragma unroll
            for (int j = 0; j < 4; ++j) { v[j] = xr[64 * j]; s += (v[j].x * v[j].x + v[j].y * v[j].y) + (v[j].z * v[j].z + v[j].w * v[j].w); }
            s = wave_sum(s);
            if (lane == 0) SS[m] = s;
            GAS unsigned long long* o8 = (GAS unsigned long long*)(HB + (size_t)m * D) + lane;
#pragma unroll
            for (int j = 0; j < 4; ++j) o8[64 * j] = (unsigned long long)pk2(v[j].x, v[j].y) | ((unsigned long long)pk2(v[j].z, v[j].w) << 32);
        }
        for (int i = vcu * (NWAVES * 64) + tid; i < 3 * M; i += G * NWAVES * 64) SS[M + i] = 0.f;
    }
    SEAM(0);
    if (IN(1)) {
        pg8::Gemm g{HB, WGU1, HB, WGU1, D}; pg8::StaticOrder S; S.init(M, NGU, G, bx);
        pg8::EpiSwiGLU E{HID, SS, FF};
        pg8::gemm_phase<pg8::EpiSwiGLU, pg8::StaticOrder, true, true>(lds + RING_OFF, g, S, E);
    }
    SEAM(1);
    if (IN(2)) {
        pg8::Gemm g{HID, WD1, HID, WD1, FF}; pg8::StaticOrder S; S.init(M, D, G, bx);
        pg8::EpiResid E{x, out, HB, SS + M, 0.5f};
        pg8::gemm_phase<pg8::EpiResid, pg8::StaticOrder, true, true>(lds + RING_OFF, g, S, E);
    }
    SEAM(2);
    if (IN(3)) {
        pg8::Gemm g{HB, WIN + (size_t)4096 * D, HB, WIN + (size_t)4096 * D, D}; pg8::StaticOrder S; S.init(M, NATT, G, bx);
        pg8::EpiProj E{AQKV, NATT, AQKV, NATT, 1 << 30, SS + M};
        pg8::gemm_phase<pg8::EpiProj, pg8::StaticOrder, true, true>(lds + RING_OFF, g, S, E);
    }
    SEAM(3);
    if (IN(4)) {
#if ATTN_NAIVE
        attn_naive(AQKV, YB, (LAS float*)(lds + RING_OFF) + wave * 64, gw, NGW, lane);
#else
        attn_phase(AQKV, YB, (bf16*)(ws + WS_O2S), (float*)(ws + WS_LSE), lds + RING_OFF, vcu, G, wave, lane);
#endif
    }
    SEAM(4);
    if (IN(5)) {
        pg8::Gemm g{HB, WIN, HB, WIN, D}; pg8::StaticOrder S; S.init(M, NHG + NGATE, G, bx);
        pg8::EpiProj E{HQ, NHG, GATES, NGATE, NHG / 256, SS + M};
        pg8::gemm_phase<pg8::EpiProj, pg8::StaticOrder, true, true>(lds + RING_OFF, g, S, E);
    }
    SEAM(5);
    if (IN(6)) { hgrn_naive(HQ, hg_lb, hg_onorm, YA, lds + RING_OFF, tid); }
    SEAM(6);
    if (IN(7)) {
        pg8::Gemm g{YA, WA, YB, WB, 512}; pg8::MergeOrder S; S.init(M, D, G, bx);
        pg8::EpiMerge E{GATES, TMP, MERGED};
        pg8::gemm_phase<pg8::EpiMerge, pg8::MergeOrder, true, true>(lds + RING_OFF, g, S, E);
    }
    SEAM(7);
    if (IN(8)) {
        pg8::Gemm g{MERGED, WO, MERGED, WO, D}; pg8::StaticOrder S; S.init(M, D, G, bx);
        pg8::EpiResid E{out, out, HB, SS + 2 * M, 1.0f};
        pg8::gemm_phase<pg8::EpiResid, pg8::StaticOrder, true, true>(lds + RING_OFF, g, S, E);
    }
    SEAM(8);
    if (IN(9)) {
        pg8::Gemm g{HB, WGU2, HB, WGU2, D}; pg8::StaticOrder S; S.init(M, NGU, G, bx);
        pg8::EpiSwiGLU E{HID, SS + 2 * M, FF};
        pg8::gemm_phase<pg8::EpiSwiGLU, pg8::StaticOrder, true, true>(lds + RING_OFF, g, S, E);
    }
    SEAM(9);
    if (IN(10)) {
        pg8::Gemm g{HID, WD2, HID, WD2, FF}; pg8::StaticOrder S; S.init(M, D, G, bx);
        pg8::EpiResid E{out, out, HB, SS + 3 * M, 0.5f};
        pg8::gemm_phase<pg8::EpiResid, pg8::StaticOrder, true, true>(lds + RING_OFF, g, S, E);
    }
    SEAM(10);
    if (IN(11)) {
        for (int m = gw; m < M; m += NGW) {
            GAS f32x4* r = (GAS f32x4*)(out + (size_t)m * D) + lane; const GAS f32x4* gn = (const GAS f32x4*)final_norm + lane;
            const float rs = rsqrtf(SS[3 * M + m] * (1.0f / D) + EPS);
#pragma unroll
            for (int j = 0; j < 4; ++j) { f32x4 v = r[64 * j]; v = v * rs * gn[64 * j]; r[64 * j] = v; }
        }
    }
#undef IN
#undef SEAM
}

extern "C" void kernel_launch(void* const* d_in, const int* in_sizes, int n_in, void* d_out, int out_size, void* d_ws, size_t ws_size, hipStream_t stream) {
    static int grid = 0;
    if (grid == 0) {
        if (n_in != 15 || out_size != M * D || ws_size < WS_END) { fprintf(stderr, "kernel_launch: unexpected shapes (n_in %d out %d ws %zu)\n", n_in, out_size, ws_size); grid = -1; return; }
        int dev = 0, cus = 0;
        if (hipGetDevice(&dev) != hipSuccess || hipDeviceGetAttribute(&cus, hipDeviceAttributeMultiprocessorCount, dev) != hipSuccess) { grid = -1; return; }
        grid = cus;
    }
    if (grid < 0) return;
    if (hipMemsetAsync((char*)d_ws + WS_CTL, 0, CTL_ZERO_BYTES, stream) != hipSuccess) return;
    Args a{};
    for (int i = 0; i < 15; ++i) a.in[i] = (const float*)d_in[i];
    a.out = (float*)d_out; a.ws = (unsigned char*)d_ws;
    for (int li = 0; li < N_LAUNCHES; ++li) {
        a.ph_lo = (N_LAUNCHES == 1) ? 0 : li; a.ph_hi = (N_LAUNCHES == 1) ? N_PHASES : li + 1; a.li = li;
        hipLaunchKernelGGL(mk_fwd, dim3(grid), dim3(NWAVES * 64), 0, stream, a);
    }
}
```

```cpp
#include <hip/hip_runtime.h>
#include <cstdio>
#include <cstdint>
namespace pg8 {
#define PG8_LAS __attribute__((address_space(3)))
typedef unsigned short bf16_t;
typedef short bf16x8 __attribute__((ext_vector_type(8)));
typedef float f32x4 __attribute__((ext_vector_type(4)));
typedef unsigned u32x4 __attribute__((ext_vector_type(4)));
constexpr int BM = 256, BK = 64, HALF = 128, HTB = HALF * BK * 2  , STAGE_BYTES = 8 * HTB, NXCD = 8, WGM = 8;

__host__ __device__ __forceinline__ int lds_byte(int r, int c) { const int st = (r >> 4) * 2 + (c >> 5), rr = r & 15, cc = c & 31, ob = rr * 64 + cc * 2; return st * 1024 + (ob ^ (((ob >> 9) & 1) << 5)); }
__host__ __device__ __forceinline__ void stage_rc(int b, int& R, int& C) { const int st = b / 1024, sb = b % 1024, swz = sb ^ (((sb >> 9) & 1) << 5); R = (st >> 1) * 16 + swz / 64; C = (st & 1) * 32 + (swz % 64) / 2; }
__host__ __device__ __forceinline__ int perm32(int rho) { const int n = rho >> 4, i = rho & 15; return 8 * (i >> 2) + 4 * n + (i & 3); }

struct Unit { int pm, pn, z; };
struct Gemm { const bf16_t* A; const bf16_t* Bt; const bf16_t* A1; const bf16_t* Bt1; int K; };

struct StaticOrder {
    int nM, nN, nwg, G, c;
    __host__ __device__ void init(int M, int N, int G_, int c_) { nM = M / BM; nN = N / BM; nwg = nM * nN; G = G_; c = c_; }
    __host__ __device__ bool next(int i, Unit& u) const {
        const long L = (long)i * G + c; if (L >= nwg) return false;
        int wgid = (int)L; { const int q = nwg / NXCD, r = nwg % NXCD, xcd = wgid % NXCD, off = wgid / NXCD; wgid = (xcd < r ? xcd * (q + 1) : r * (q + 1) + (xcd - r) * q) + off; }
        const int nig = WGM * nN, gid = wgid / nig, fm = gid * WGM, gsz = (nM - fm) < WGM ? (nM - fm) : WGM;
        u.pm = fm + ((wgid % nig) % gsz); u.pn = (wgid % nig) / gsz; u.z = 0; return true;
    }
    __device__ __forceinline__ void a_ready(const Unit&) const {}
    __device__ __forceinline__ void done(const Unit&) const {}
};


__device__ __forceinline__ unsigned cvt_pk_bf16(float lo, float hi) { unsigned r; asm volatile("v_cvt_pk_bf16_f32 %0, %1, %2" : "=v"(r) : "v"(lo), "v"(hi)); return r; }
typedef float f32x2 __attribute__((ext_vector_type(2)));
__device__ __forceinline__ float fast_sigmoid(float x) { return __builtin_amdgcn_rcpf(1.0f + __builtin_amdgcn_exp2f(-1.4426950408889634f * x)); }
__device__ __forceinline__ float bf_lo(unsigned w) { return __uint_as_float(w << 16); }
__device__ __forceinline__ float bf_hi(unsigned w) { return __uint_as_float(w & 0xffff0000u); }
__device__ __forceinline__ float row_rstd(const float* ss, int row) { return rsqrtf(ss[row] * (1.0f / 1024.0f) + 1e-6f); }
__device__ __forceinline__ u32x4 pack8(const float (&h)[8]) { u32x4 w; w.x = cvt_pk_bf16(h[0], h[1]); w.y = cvt_pk_bf16(h[2], h[3]); w.z = cvt_pk_bf16(h[4], h[5]); w.w = cvt_pk_bf16(h[6], h[7]); return w; }

struct EpiSwiGLU {
    static constexpr bool PERM = true, AFTER_DRAIN = false;
    bf16_t* O; const float* ss; int ldo;
    __device__ __forceinline__ void operator()(const f32x4 (&acc)[2][2][4][2], const Unit& u, int wr, int wc, int fr, int fq) const {
        const int row0 = u.pm * BM + wr * 64 + fr, col0 = u.pn * 128 + wc * 32 + 8 * fq;
#pragma unroll
        for (int ai = 0; ai < 2; ++ai)
#pragma unroll
            for (int m = 0; m < 4; ++m) {
                const int row = row0 + ai * HALF + m * 16; const float rs = row_rstd(ss, row);
                float h[8];
#pragma unroll
                for (int n = 0; n < 2; ++n)
#pragma unroll
                    for (int i = 0; i < 4; ++i) { const float g = acc[ai][0][m][n][i] * rs, up = acc[ai][1][m][n][i] * rs; h[4 * n + i] = g * fast_sigmoid(g) * up; }
                *(u32x4*)(O + (size_t)row * ldo + col0) = pack8(h);
            }
    }
};
struct EpiResid {
    static constexpr bool PERM = true, AFTER_DRAIN = false;
    const float* base; float* outf; bf16_t* hb; float* ss_out; float scale;
    __device__ __forceinline__ void operator()(const f32x4 (&acc)[2][2][4][2], const Unit& u, int wr, int wc, int fr, int fq) const {
        const int row0 = u.pm * BM + wr * 64 + fr;
#pragma unroll
        for (int ai = 0; ai < 2; ++ai)
#pragma unroll
            for (int m = 0; m < 4; ++m) {
                const int row = row0 + ai * HALF + m * 16; float ssq = 0.f;
#pragma unroll
                for (int bj = 0; bj < 2; ++bj) {
                    const size_t off = (size_t)row * 1024 + u.pn * BM + bj * HALF + wc * 32 + 8 * fq;
                    const f32x4 b0 = *(const f32x4*)(base + off), b1 = *(const f32x4*)(base + off + 4);
                    const f32x4 v0 = b0 + acc[ai][bj][m][0] * scale, v1 = b1 + acc[ai][bj][m][1] * scale;
                    *(f32x4*)(outf + off) = v0; *(f32x4*)(outf + off + 4) = v1;
                    const float h[8] = {v0[0], v0[1], v0[2], v0[3], v1[0], v1[1], v1[2], v1[3]};
                    *(u32x4*)(hb + off) = pack8(h);
#pragma unroll
                    for (int i = 0; i < 8; ++i) ssq += h[i] * h[i];
                }
                ssq += __shfl_xor(ssq, 16); ssq += __shfl_xor(ssq, 32);
                if (fq == 0) atomicAdd(ss_out + row, ssq);
            }
    }
};
struct EpiProj {
    static constexpr bool PERM = true, AFTER_DRAIN = false;
    bf16_t* o1; int ld1; bf16_t* o2; int ld2; int split_pn; const float* ss;
    __device__ __forceinline__ void operator()(const f32x4 (&acc)[2][2][4][2], const Unit& u, int wr, int wc, int fr, int fq) const {
        const int row0 = u.pm * BM + wr * 64 + fr; const bool second = u.pn >= split_pn;
        bf16_t* dst = second ? o2 : o1; const int ld = second ? ld2 : ld1; const int colt = (second ? u.pn - split_pn : u.pn) * BM + wc * 32 + 8 * fq;
#pragma unroll
        for (int ai = 0; ai < 2; ++ai)
#pragma unroll
            for (int m = 0; m < 4; ++m) {
                const int row = row0 + ai * HALF + m * 16; const float rs = row_rstd(ss, row);
#pragma unroll
                for (int bj = 0; bj < 2; ++bj) {
                    float h[8];
#pragma unroll
                    for (int n = 0; n < 2; ++n)
#pragma unroll
                        for (int i = 0; i < 4; ++i) { const float v = acc[ai][bj][m][n][i] * rs; h[4 * n + i] = second ? fast_sigmoid(v) : v; }
                    *(u32x4*)(dst + (size_t)row * ld + colt + bj * HALF) = pack8(h);
                }
            }
    }
};
struct EpiMerge {
    static constexpr bool PERM = true, AFTER_DRAIN = false;
    const bf16_t* gates; bf16_t* tmp; bf16_t* merged;
    __device__ __forceinline__ void operator()(const f32x4 (&acc)[2][2][4][2], const Unit& u, int wr, int wc, int fr, int fq) const {
        const int row0 = u.pm * BM + wr * 64 + fr;
#pragma unroll
        for (int ai = 0; ai < 2; ++ai)
#pragma unroll
            for (int m = 0; m < 4; ++m) {
                const int row = row0 + ai * HALF + m * 16;
#pragma unroll
                for (int bj = 0; bj < 2; ++bj) {
                    const int col = u.pn * BM + bj * HALF + wc * 32 + 8 * fq;
                    const u32x4 gw = *(const u32x4*)(gates + (size_t)row * 2048 + u.z * 1024 + col);
                    const float gt[8] = {bf_lo(gw.x), bf_hi(gw.x), bf_lo(gw.y), bf_hi(gw.y), bf_lo(gw.z), bf_hi(gw.z), bf_lo(gw.w), bf_hi(gw.w)};
                    float h[8];
#pragma unroll
                    for (int n = 0; n < 2; ++n)
#pragma unroll
                        for (int i = 0; i < 4; ++i) h[4 * n + i] = acc[ai][bj][m][n][i] * gt[4 * n + i];
                    if (u.z) {
                        const u32x4 tw = *(const u32x4*)(tmp + (size_t)row * 1024 + col);
                        h[0] += bf_lo(tw.x); h[1] += bf_hi(tw.x); h[2] += bf_lo(tw.y); h[3] += bf_hi(tw.y); h[4] += bf_lo(tw.z); h[5] += bf_hi(tw.z); h[6] += bf_lo(tw.w); h[7] += bf_hi(tw.w);
                        *(u32x4*)(merged + (size_t)row * 1024 + col) = pack8(h);
                    } else *(u32x4*)(tmp + (size_t)row * 1024 + col) = pack8(h);
                }
            }
    }
};
struct MergeOrder : StaticOrder {
    __host__ __device__ bool next(int i, Unit& u) const { if (!StaticOrder::next(i >> 1, u)) return false; u.z = i & 1; return true; }
};

template <class Epi, class Sched, bool ALIGN_EPI = false, bool SP2 = false>
__device__ __forceinline__ void gemm_phase(PG8_LAS unsigned char* lds, const Gemm g, const Sched& S, const Epi& E) {
    const int tid = threadIdx.x, wid = __builtin_amdgcn_readfirstlane(tid >> 6), lane = tid & 63, wr = wid >> 2, wc = wid & 3, fr = lane & 15, fq = lane >> 4;
    const int K = g.K, nt = K / BK;
    unsigned voffA[2], voffB[2];
#pragma unroll
    for (int i = 0; i < 2; ++i) { int R, C; stage_rc(tid * 16 + i * 8192, R, C); const int Rb = Epi::PERM ? ((R & ~31) + perm32(R & 31)) : R;
        voffA[i] = (unsigned)(R * K + C) * 2u; voffB[i] = (unsigned)(Rb * K + C) * 2u; }
    const size_t kstep = (size_t)(BK * 2);
    const size_t hstep = (size_t)HALF * K * 2;
    const size_t tstep = 2 * hstep;
    const unsigned ldsw = (unsigned)wid * 1024u;
    const int aoff = lds_byte(wr * 64 + fr, fq * 8), boff = lds_byte(wc * 32 + fr, fq * 8);
#define PG8_SA(b, h) (((b) * 2 + (h)) * HTB)
#define PG8_SB(b, h) ((4 + (b) * 2 + (h)) * HTB)
#define PG8_STAGE(bufoff, gbase, voff) do { _Pragma("unroll") for (int _i = 0; _i < 2; ++_i) \
        __builtin_amdgcn_global_load_lds((const unsigned*)((const char*)(gbase) + (voff)[_i]), (PG8_LAS unsigned*)(lds + (bufoff) + ldsw + _i * 8192), 16, 0, 0); } while (0)
#define PG8_LDA(dst, b, h) do { _Pragma("unroll") for (int m = 0; m < 4; ++m) _Pragma("unroll") for (int k = 0; k < 2; ++k) dst[m][k] = *(const PG8_LAS bf16x8*)(lds + PG8_SA(b, h) + aoff + m * 2048 + k * 1024); } while (0)
#define PG8_LDB(dst, b, h) do { _Pragma("unroll") for (int n = 0; n < 2; ++n) _Pragma("unroll") for (int k = 0; k < 2; ++k) dst[n][k] = *(const PG8_LAS bf16x8*)(lds + PG8_SB(b, h) + boff + n * 2048 + k * 1024); } while (0)
#define PG8_MMA(ai, bj, At, Bt) do { __builtin_amdgcn_s_setprio(1); _Pragma("unroll") for (int m = 0; m < 4; ++m) _Pragma("unroll") for (int n = 0; n < 2; ++n) _Pragma("unroll") for (int k = 0; k < 2; ++k) \
        acc[ai][bj][m][n] = __builtin_amdgcn_mfma_f32_16x16x32_bf16(Bt[n][k], At[m][k], acc[ai][bj][m][n], 0, 0, 0); __builtin_amdgcn_s_setprio(0); } while (0)
#define PG8_WAIT_V(n) asm volatile("s_waitcnt vmcnt(" #n ")" ::: "memory")
#define PG8_WAIT_L(n) asm volatile("s_waitcnt lgkmcnt(" #n ")" ::: "memory")
#define PG8_BAR __builtin_amdgcn_s_barrier()
#define PG8_SCHED __builtin_amdgcn_sched_barrier(0)
    Unit cur, nxt; int ui = 0;
    if (!S.next(0, cur)) return;
    f32x4 acc[2][2][4][2];
#pragma unroll
    for (int a = 0; a < 2; ++a)
#pragma unroll
        for (int b = 0; b < 2; ++b)
#pragma unroll
            for (int m = 0; m < 4; ++m)
#pragma unroll
                for (int n = 0; n < 2; ++n) acc[a][b][m][n] = (f32x4){0.f, 0.f, 0.f, 0.f};
    bf16x8 At[4][2], B0[2][2], B1[2][2];
    const char* cA = (const char*)(cur.z ? g.A1 : g.A) + (size_t)cur.pm * tstep; const char* cB = (const char*)(cur.z ? g.Bt1 : g.Bt) + (size_t)cur.pn * tstep;
    S.a_ready(cur);
    if constexpr (SP2) {
        PG8_STAGE(PG8_SB(0, 0), cB, voffB); PG8_STAGE(PG8_SB(0, 1), cB + hstep, voffB); PG8_STAGE(PG8_SA(0, 0), cA, voffA); PG8_STAGE(PG8_SA(0, 1), cA + hstep, voffA);
        if (wr == 1) PG8_BAR;
        PG8_WAIT_V(2); PG8_BAR;
        PG8_STAGE(PG8_SB(1, 0), cB + kstep, voffB); PG8_STAGE(PG8_SA(1, 0), cA + kstep, voffA); PG8_STAGE(PG8_SB(1, 1), cB + hstep + kstep, voffB);
        PG8_WAIT_V(6); PG8_BAR;
    } else {
        PG8_STAGE(PG8_SB(0, 0), cB, voffB); PG8_STAGE(PG8_SA(0, 0), cA, voffA); PG8_STAGE(PG8_SB(0, 1), cB + hstep, voffB); PG8_STAGE(PG8_SA(0, 1), cA + hstep, voffA);
        if (wr == 1) PG8_BAR;
        PG8_WAIT_V(4); PG8_BAR;
        PG8_STAGE(PG8_SB(1, 0), cB + kstep, voffB); PG8_STAGE(PG8_SA(1, 0), cA + kstep, voffA); PG8_STAGE(PG8_SB(1, 1), cB + hstep + kstep, voffB);
        PG8_WAIT_V(6); PG8_BAR;
    }
    for (;;) {
        const bool has_next = S.next(ui + 1, nxt);
        const char* nA = has_next ? (const char*)(nxt.z ? g.A1 : g.A) + (size_t)nxt.pm * tstep : cA; const char* nB = has_next ? (const char*)(nxt.z ? g.Bt1 : g.Bt) + (size_t)nxt.pn * tstep : cB;
        for (int t = 0; t < nt; t += 2) {
            const bool last = (t == nt - 2);
            const char* a1 = cA + (size_t)(t + 1) * kstep;
            const char* a2 = last ? nA : cA + (size_t)(t + 2) * kstep; const char* b2 = last ? nB : cB + (size_t)(t + 2) * kstep;
            const char* a3 = a2 + kstep; const char* b3 = b2 + kstep;
            if (last && has_next) S.a_ready(nxt);
            if constexpr (SP2) {
            PG8_LDB(B0, 0, 0); PG8_LDB(B1, 0, 1); PG8_SCHED; PG8_LDA(At, 0, 0); PG8_STAGE(PG8_SA(1, 1), a1 + hstep, voffA);
            PG8_WAIT_V(8); PG8_WAIT_L(0); PG8_BAR; PG8_MMA(0, 0, At, B0); PG8_MMA(0, 1, At, B1); PG8_BAR; PG8_SCHED;
            PG8_LDA(At, 0, 1); PG8_STAGE(PG8_SB(0, 0), b2, voffB); PG8_STAGE(PG8_SB(0, 1), b2 + hstep, voffB); PG8_STAGE(PG8_SA(0, 0), a2, voffA);
            PG8_WAIT_V(8); PG8_WAIT_L(0); PG8_BAR; PG8_MMA(1, 0, At, B0); PG8_MMA(1, 1, At, B1); PG8_BAR; PG8_SCHED;
            PG8_LDB(B0, 1, 0); PG8_LDB(B1, 1, 1); PG8_SCHED; PG8_LDA(At, 1, 0); PG8_STAGE(PG8_SA(0, 1), a2 + hstep, voffA);
            PG8_WAIT_V(8); PG8_WAIT_L(0); PG8_BAR; PG8_MMA(0, 0, At, B0); PG8_MMA(0, 1, At, B1); PG8_BAR; PG8_SCHED;
            PG8_LDA(At, 1, 1); PG8_STAGE(PG8_SB(1, 0), b3, voffB); PG8_STAGE(PG8_SB(1, 1), b3 + hstep, voffB); PG8_STAGE(PG8_SA(1, 0), a3, voffA);
            PG8_WAIT_V(8); PG8_WAIT_L(0); PG8_BAR; PG8_MMA(1, 0, At, B0); PG8_MMA(1, 1, At, B1); PG8_BAR; PG8_SCHED;
            } else {
            PG8_LDB(B0, 0, 0); PG8_SCHED; PG8_LDA(At, 0, 0); PG8_STAGE(PG8_SA(1, 1), a1 + hstep, voffA);
            PG8_WAIT_L(8); PG8_BAR; PG8_WAIT_L(0); PG8_MMA(0, 0, At, B0); PG8_BAR; PG8_SCHED;
            PG8_LDB(B1, 0, 1); PG8_STAGE(PG8_SB(0, 0), b2, voffB);
            PG8_BAR; PG8_WAIT_L(0); PG8_MMA(0, 1, At, B1); PG8_BAR;
            PG8_LDA(At, 0, 1); PG8_STAGE(PG8_SA(0, 0), a2, voffA);
            PG8_BAR; PG8_WAIT_L(0); PG8_MMA(1, 0, At, B0); PG8_BAR; PG8_SCHED;
            PG8_STAGE(PG8_SB(0, 1), b2 + hstep, voffB);
            PG8_WAIT_V(6); PG8_BAR; PG8_MMA(1, 1, At, B1); PG8_BAR;
            PG8_LDB(B0, 1, 0); PG8_SCHED; PG8_LDA(At, 1, 0); PG8_STAGE(PG8_SA(0, 1), a2 + hstep, voffA);
            PG8_WAIT_L(8); PG8_BAR; PG8_WAIT_L(0); PG8_MMA(0, 0, At, B0); PG8_BAR; PG8_SCHED;
            PG8_LDB(B1, 1, 1); PG8_STAGE(PG8_SB(1, 0), b3, voffB);
            PG8_BAR; PG8_WAIT_L(0); PG8_MMA(0, 1, At, B1); PG8_BAR;
            PG8_LDA(At, 1, 1); PG8_STAGE(PG8_SA(1, 0), a3, voffA);
            PG8_BAR; PG8_WAIT_L(0); PG8_MMA(1, 0, At, B0); PG8_BAR; PG8_SCHED;
            PG8_STAGE(PG8_SB(1, 1), b3 + hstep, voffB);
            PG8_WAIT_V(6); PG8_BAR; PG8_MMA(1, 1, At, B1); PG8_BAR;
            }
        }
        if constexpr (ALIGN_EPI) { if (wr == 0) PG8_BAR; }
        if constexpr (!Epi::AFTER_DRAIN) { E(acc, cur, wr, wc, fr, fq); S.done(cur); }
        if (!has_next) break;
#pragma unroll
        for (int a = 0; a < 2; ++a)
#pragma unroll
            for (int b = 0; b < 2; ++b)
#pragma unroll
                for (int m = 0; m < 4; ++m)
#pragma unroll
                    for (int n = 0; n < 2; ++n) acc[a][b][m][n] = (f32x4){0.f, 0.f, 0.f, 0.f};
        cur = nxt; cA = nA; cB = nB; ++ui;
        if constexpr (ALIGN_EPI) { if (wr == 1) PG8_BAR; }
    }
    PG8_WAIT_V(0);
    if constexpr (!ALIGN_EPI) { if (wr == 0) PG8_BAR; }
    PG8_BAR;
    if constexpr (Epi::AFTER_DRAIN) { E.fused(acc, cur, wr, wc, fr, fq, lds, wid, lane); S.done(cur); }
#undef PG8_SA
#undef PG8_SB
#undef PG8_STAGE
#undef PG8_LDA
#undef PG8_LDB
#undef PG8_MMA
#undef PG8_WAIT_V
#undef PG8_WAIT_L
#undef PG8_BAR
#undef PG8_SCHED
}
}

#define GAS __attribute__((address_space(1)))
#define LAS __attribute__((address_space(3)))
typedef unsigned short bf16;
typedef unsigned v4u __attribute__((ext_vector_type(4)));
typedef float f32x4 __attribute__((ext_vector_type(4)));
typedef short bf16x8 __attribute__((ext_vector_type(8)));
typedef GAS unsigned gu32;
typedef GAS unsigned long long gu64;
#define RLX_AGENT __ATOMIC_RELAXED, __HIP_MEMORY_SCOPE_AGENT
#define LDS_WAIT() asm volatile("s_waitcnt lgkmcnt(0)" ::: "memory")
#define VM_WAIT() asm volatile("s_waitcnt vmcnt(0)" ::: "memory")
__device__ __forceinline__ unsigned long long rt() { return __builtin_amdgcn_s_memrealtime(); }
__device__ __forceinline__ unsigned f2bf(float f) { unsigned u = __builtin_bit_cast(unsigned, f); return (u + 0x7fffu + ((u >> 16) & 1u)) >> 16; }
__device__ __forceinline__ unsigned pk2(float lo, float hi) { return f2bf(lo) | (f2bf(hi) << 16); }
#define XB_TMO      128
#define XB_XCNT(j)  (256  + 64 * (j))
#define XB_XSUB(j)  (1280 + 64 * (j))
#define XB_XGEN(j)  (2304 + 64 * (j))
#define XB_TOP      3328
#define XB_TOPGEN   3392
#define XCD_BAR_WORDS 3456
#define XB_SPIN_CAP (1u << 18)

__device__ __forceinline__ unsigned xb_ld(unsigned* p)              { return __hip_atomic_load(p, __ATOMIC_RELAXED, __HIP_MEMORY_SCOPE_AGENT); }
__device__ __forceinline__ unsigned xb_add(unsigned* p, unsigned v) { return __hip_atomic_fetch_add(p, v, __ATOMIC_RELAXED, __HIP_MEMORY_SCOPE_AGENT); }
__device__ __forceinline__ unsigned xb_xcc_id() { return (unsigned)__builtin_amdgcn_s_getreg((3 << 11) | 20) & 0xFu; }
#define XB_SPIN(cond, bar) do { unsigned _sp = 0; while (cond) { __builtin_amdgcn_s_sleep(1); \
    if ((++_sp & 255u) == 0u) { if (xb_ld(&(bar)[XB_TMO])) break; if (_sp > XB_SPIN_CAP) { atomicAdd(&(bar)[XB_TMO], 1u); break; } } } } while (0)

struct XcdBarrier {
    unsigned* bar; unsigned x;
    volatile LAS unsigned* st;
};

__device__ __forceinline__ XcdBarrier xcd_barrier_post(unsigned* bar, volatile LAS unsigned* st) {
    XcdBarrier b; b.bar = bar; b.x = xb_xcc_id(); b.st = st;
    if (threadIdx.x == 0) (void)xb_add(&bar[XB_XCNT(b.x)], 1u);
    return b;
}
__device__ __forceinline__ void xcd_barrier_complete(unsigned* bar, unsigned x, unsigned& nloc, unsigned& nx) {
    const unsigned G = gridDim.x * gridDim.y * gridDim.z;
    unsigned sum, cnt, mine, sp = 0u;
    for (;;) {
        sum = 0u; cnt = 0u; mine = 0u;
#pragma unroll
        for (unsigned j = 0; j < 16; ++j) { const unsigned c = xb_ld(&bar[XB_XCNT(j)]); sum += c; cnt += (c > 0u) ? 1u : 0u; mine = (j == x) ? c : mine; }
        if (sum == G) break;
        __builtin_amdgcn_s_sleep(1);
        if ((++sp & 255u) == 0u) { if (xb_ld(&bar[XB_TMO])) break; if (sp > XB_SPIN_CAP) { atomicAdd(&bar[XB_TMO], 1u); break; } }
    }
    nloc = mine > 0u ? mine : 1u; nx = cnt > 0u ? cnt : 1u;
}

__device__ __forceinline__ void xcd_barrier(const XcdBarrier& b) {
    asm volatile("s_waitcnt vmcnt(0)" ::: "memory");
    __syncthreads();
    if (threadIdx.x == 0) {
        unsigned* bar = b.bar;
        __builtin_amdgcn_s_waitcnt(0);
        unsigned nloc = b.st[0], nx = b.st[1];
        if (nloc == 0u) { xcd_barrier_complete(bar, b.x, nloc, nx); b.st[0] = nloc; b.st[1] = nx; }
        const unsigned old = xb_add(&bar[XB_XSUB(b.x)], 1u);
        const unsigned gen = old / nloc;
        if (old + 1u == (gen + 1u) * nloc) {
            __builtin_amdgcn_fence(__ATOMIC_RELEASE, "agent");
            asm volatile("s_waitcnt vmcnt(0)" ::: "memory");
            const unsigned og = xb_add(&bar[XB_TOP], 1u);
            const unsigned tg = og / nx;
            if (og + 1u == (tg + 1u) * nx) xb_add(&bar[XB_TOPGEN], 1u);
            else XB_SPIN(xb_ld(&bar[XB_TOPGEN]) == tg, bar);
            __builtin_amdgcn_fence(__ATOMIC_ACQUIRE, "agent");
            xb_add(&bar[XB_XGEN(b.x)], 1u);
            asm volatile("s_waitcnt vmcnt(0)" ::: "memory");
        } else {
            XB_SPIN(xb_ld(&bar[XB_XGEN(b.x)]) == gen, bar);
            __builtin_amdgcn_fence(__ATOMIC_ACQUIRE, "agent");
            asm volatile("s_waitcnt vmcnt(0)" ::: "memory");
        }
    }
    __syncthreads();
}

constexpr int NWAVES = 8;
#ifndef HGRN_NAIVE
#define HGRN_NAIVE 0
#endif
#ifndef ATTN_NAIVE
#define ATTN_NAIVE 0
#endif
#ifndef MK_N_LAUNCHES
#define MK_N_LAUNCHES 1
#endif
constexpr int N_PHASES = 13;
constexpr int N_LAUNCHES = MK_N_LAUNCHES;

constexpr int M = 16384, SEQ = 2048, D = 1024, FF = 2816, NGU = 2 * FF, NIN = 8704, NATT = 4608, NHG = 2048, NGATE = 2048;
constexpr float EPS = 1e-6f;

constexpr size_t MiB = 1u << 20;
constexpr size_t WS_CTL = 0, CTL_ZERO_BYTES = 1 * MiB;
constexpr size_t WS_SS = 1 * MiB;
constexpr size_t WS_WGU1 = 2 * MiB, WS_WD1 = 13 * MiB, WS_WGU2 = 18 * MiB + 512 * 1024, WS_WD2 = 29 * MiB + 512 * 1024, WS_WIN = 35 * MiB, WS_WA = 52 * MiB, WS_WB = 53 * MiB, WS_WO = 54 * MiB;
constexpr size_t WS_HB = 56 * MiB;
constexpr size_t WS_BIG = 88 * MiB;
constexpr size_t WS_HID = WS_BIG;
constexpr size_t WS_AQKV = WS_BIG, WS_YB = 232 * MiB;
constexpr size_t WS_HQ = WS_BIG, WS_GATES = 152 * MiB, WS_YA = 216 * MiB;
constexpr size_t WS_TMP = WS_BIG, WS_MERGED = 120 * MiB;
constexpr size_t WS_O2S = 2 * MiB, WS_LSE = 248 * MiB;
constexpr size_t WS_LST = 2 * MiB, WS_DLG = 249 * MiB;
constexpr size_t WS_END = 256 * MiB;
static_assert(WS_WGU1 + (size_t)NGU * D * 2 <= WS_WD1 && WS_WD1 + (size_t)D * FF * 2 <= WS_WGU2 && WS_WGU2 + (size_t)NGU * D * 2 <= WS_WD2 && WS_WD2 + (size_t)D * FF * 2 <= WS_WIN && WS_WIN + (size_t)NIN * D * 2 <= WS_WA, "ws map: weights");
static_assert(WS_HB + (size_t)M * D * 2 <= WS_BIG && WS_HID + (size_t)M * FF * 2 <= WS_END && WS_AQKV + (size_t)M * NATT * 2 <= WS_YB && WS_YB + (size_t)M * 512 * 2 <= WS_END, "ws map: acts");
static_assert(WS_HQ + (size_t)M * NHG * 2 <= WS_GATES && WS_GATES + (size_t)M * NGATE * 2 <= WS_YA && WS_YA + (size_t)M * 512 * 2 <= WS_YB && WS_TMP + (size_t)M * D * 2 <= WS_MERGED && WS_MERGED + (size_t)M * D * 2 <= WS_GATES, "ws map: mixer");
constexpr int CW_BAR = 4096;

constexpr int RING_OFF = 0, RING_BYTES = 131072;
constexpr int LDSCTL_OFF = RING_BYTES, MISC_OFF = LDSCTL_OFF + 320;
constexpr int LDS_BYTES = 147456;

__device__ __forceinline__ float bf2f(bf16 x) { return __uint_as_float((unsigned)x << 16); }
__device__ __forceinline__ float wave_sum(float v) {
#pragma unroll
    for (int o = 1; o < 64; o <<= 1) v += __shfl_xor(v, o);
    return v;
}
__device__ __forceinline__ float wave_max(float v) {
#pragma unroll
    for (int o = 1; o < 64; o <<= 1) v = fmaxf(v, __shfl_xor(v, o));
    return v;
}
__device__ __forceinline__ float sigmoidf_(float x) { return 1.0f / (1.0f + __expf(-x)); }

__device__ __forceinline__ void p0_transpose_item(const float* W, const float* gain, int K, int N, bf16* WT, int mapmode, LAS float* scr, int item, int lane) {
    const int nblk = N / 32, kb = item / nblk, nb = item % nblk, k0 = 64 * kb, n0 = 32 * nb;
    int d0;
    if (mapmode == 1) { const int bj = n0 >= FF ? 1 : 0, c = n0 - bj * FF; d0 = (c >> 7) * 256 + bj * 128 + (c & 127); }
    else if (mapmode == 2) { d0 = n0 < 2048 ? n0 : (n0 < 6656 ? 4096 + (n0 - 2048) : 2048 + (n0 - 6656)); }
    else d0 = n0;
#pragma unroll 8
    for (int i = 0; i < 32; ++i) { const int kk = 2 * i + (lane >> 5); const float g = gain ? gain[k0 + kk] : 1.0f; scr[kk * 33 + (lane & 31)] = W[(size_t)(k0 + kk) * N + n0 + (lane & 31)] * g; }
    LDS_WAIT(); asm volatile("" ::: "memory");
    const int c = lane & 7;
#pragma unroll
    for (int j = 0; j < 4; ++j) { const int n = (lane >> 3) + 8 * j; const LAS float* s = scr + (8 * c) * 33 + n;
        v4u o; o.x = pk2(s[0 * 33], s[1 * 33]); o.y = pk2(s[2 * 33], s[3 * 33]); o.z = pk2(s[4 * 33], s[5 * 33]); o.w = pk2(s[6 * 33], s[7 * 33]);
        *(GAS v4u*)(WT + (size_t)(d0 + n) * K + k0 + 8 * c) = o; }
    LDS_WAIT(); asm volatile("" ::: "memory");
}

__device__ __forceinline__ void hgrn_naive(const bf16* HQ, const float* lbraw, const float* onorm, bf16* YA, LAS unsigned char* lds, int tid) {
    if (blockIdx.x >= 16) return;
    constexpr int TB = 8;
    LAS f32x4* L4 = (LAS f32x4*)lds;
    LAS float* OB = (LAS float*)(lds + 2 * TB * 128 * 16);
    LAS float* WSUM = OB + 2 * TB * 2 * 128;
    const int cw = tid >> 8, kh = (tid >> 7) & 1, v = tid & 127, lane = tid & 63, wv = (tid >> 6) & 1;
    const int chain = blockIdx.x * 2 + cw, b = chain >> 2, h = chain & 3;
    const float a0 = lbraw[h * 128 + v], a1 = lbraw[512 + h * 128 + v];
    const float lb = 1.0f / (1.0f + __expf(a1 - a0));
    const float gain = onorm[h * 128 + v];
    float S[64];
#pragma unroll
    for (int k = 0; k < 64; ++k) S[k] = 0.f;
    for (int t0 = 0; t0 < SEQ; t0 += TB) {
#pragma unroll 1
        for (int tt = kh; tt < TB; tt += 2) {
            const size_t row = (size_t)b * SEQ + t0 + tt;
            const float qv = bf2f(HQ[row * 2048 + h * 128 + v]), fp = bf2f(HQ[row * 2048 + 512 + h * 128 + v]);
            const float f = lb + (1.0f - lb) * sigmoidf_(fp);
            L4[(cw * TB + tt) * 128 + v] = (f32x4){qv, f, 1.0f - f, 0.f};
        }
        __syncthreads();
#pragma unroll 1
        for (int tt = 0; tt < TB; ++tt) {
            const size_t row = (size_t)b * SEQ + t0 + tt;
            const float iv = bf2f(HQ[row * 2048 + 1024 + h * 128 + v]);
            float ot = 0.f;
#pragma unroll
            for (int kg = 0; kg < 8; ++kg) {
#pragma unroll
                for (int k8 = 0; k8 < 8; ++k8) { const int k = kg * 8 + k8; const f32x4 e = L4[(cw * TB + tt) * 128 + kh * 64 + k]; S[k] = e[1] * S[k] + e[2] * iv; ot += e[0] * S[k]; }
                __builtin_amdgcn_sched_barrier(0);
            }
            OB[((cw * TB + tt) * 2 + kh) * 128 + v] = ot;
        }
        __syncthreads();
        float o4[4];
#pragma unroll
        for (int i = 0; i < 4; ++i) {
            const int tt = 2 * i + kh;
            o4[i] = OB[((cw * TB + tt) * 2 + 0) * 128 + v] + OB[((cw * TB + tt) * 2 + 1) * 128 + v];
            const float sq = wave_sum(o4[i] * o4[i]);
            if (lane == 0) WSUM[(cw * TB + tt) * 2 + wv] = sq;
        }
        __syncthreads();
#pragma unroll
        for (int i = 0; i < 4; ++i) {
            const int tt = 2 * i + kh;
            const size_t row = (size_t)b * SEQ + t0 + tt;
            const float tot = WSUM[(cw * TB + tt) * 2] + WSUM[(cw * TB + tt) * 2 + 1];
            const float rs = rsqrtf(tot * (1.0f / 128.0f) + EPS);
            const float og = bf2f(HQ[row * 2048 + 1536 + h * 128 + v]);
            const float y = o4[i] * rs * gain * (og * sigmoidf_(og));
            YA[row * 512 + h * 128 + v] = (bf16)f2bf(y);
        }
        __syncthreads();
    }
}

__device__ __forceinline__ void attn_naive(const bf16* AQKV, bf16* YB, LAS float* wq, int gw, int NGW, int lane) {
    for (int unit = gw; unit < M * 8; unit += NGW) {
        const int row = unit >> 3, hs = unit & 7, b = row >> 11, s = row & (SEQ - 1);
        float m_run = -1e30f, l_run = 0.f, acc = 0.f;
#pragma unroll 1
        for (int g = 0; g < 3; ++g) {
            const int d = g == 0 ? 1 : (g == 1 ? 4 : 16);
            const float slope = exp2f(-8.0f * (float)(g * 8 + hs + 1) / 24.0f);
            const int qcol = g * 1536 + hs * 64, kcol = qcol + 512, vcol = qcol + 1024;
            wq[lane] = bf2f(AQKV[(size_t)row * NATT + qcol + lane]) * 0.125f;
            const int lq = s / d, nk = (lq < 128 ? lq : 128) + 1;
#pragma unroll 1
            for (int c0 = 0; c0 < nk; c0 += 64) {
                const int j = c0 + lane; const bool valid = j < nk;
                float sc = -1e30f;
                if (valid) {
                    const bf16* kr = AQKV + (size_t)(b * SEQ + s - j * d) * NATT + kcol;
                    float dot = 0.f;
#pragma unroll
                    for (int e8 = 0; e8 < 8; ++e8) {
                        const v4u w = *(const v4u*)(kr + e8 * 8);
                        dot += wq[e8 * 8 + 0] * __uint_as_float(w.x << 16) + wq[e8 * 8 + 1] * __uint_as_float(w.x & 0xffff0000u)
                             + wq[e8 * 8 + 2] * __uint_as_float(w.y << 16) + wq[e8 * 8 + 3] * __uint_as_float(w.y & 0xffff0000u)
                             + wq[e8 * 8 + 4] * __uint_as_float(w.z << 16) + wq[e8 * 8 + 5] * __uint_as_float(w.z & 0xffff0000u)
                             + wq[e8 * 8 + 6] * __uint_as_float(w.w << 16) + wq[e8 * 8 + 7] * __uint_as_float(w.w & 0xffff0000u);
                    }
                    sc = dot - slope * (float)(d * j);
                }
                const float m_new = fmaxf(m_run, wave_max(sc));
                const float p = valid ? __expf(sc - m_new) : 0.f;
                const float corr = __expf(m_run - m_new);
                l_run = l_run * corr + wave_sum(p); acc *= corr; m_run = m_new;
                const int cnt = (nk - c0) < 64 ? (nk - c0) : 64;
#pragma unroll 1
                for (int jj = 0; jj < cnt; ++jj) {
                    const float pj = __uint_as_float(__builtin_amdgcn_readlane(__float_as_uint(p), jj));
                    acc += pj * bf2f(AQKV[(size_t)(b * SEQ + s - (c0 + jj) * d) * NATT + vcol + lane]);
                }
            }
        }
        YB[(size_t)row * 512 + hs * 64 + lane] = (bf16)f2bf(acc / l_run);
    }
}

typedef float f32x16 __attribute__((ext_vector_type(16)));
typedef short s16x4 __attribute__((ext_vector_type(4)));
typedef short v4i16_t __attribute__((ext_vector_type(4)));
typedef unsigned v2u __attribute__((ext_vector_type(2)));
__device__ __forceinline__ s16x4 lds_tr(const LAS unsigned char* p) { return __builtin_bit_cast(s16x4, __builtin_amdgcn_ds_read_tr16_b64_v4i16((LAS v4i16_t*)p)); }
__device__ __forceinline__ unsigned cvtpk(float lo, float hi) { unsigned r; asm volatile("v_cvt_pk_bf16_f32 %0, %1, %2" : "=v"(r) : "v"(lo), "v"(hi)); return r; }

__device__ __forceinline__ void attn_tile(const bf16* AQKV, int b, int hs, int g, int d, int res, int l0, LAS unsigned char* vst, int lane,
                                          f32x16& o0, f32x16& o1, float& m_run, float& l_run) {
    const int r32 = lane & 31, hi = lane >> 5;
    const int qcol = g * 1536 + hs * 64, kcol = qcol + 512, vcol = qcol + 1024;
    const float slope = exp2f(-8.0f * (float)(g * 8 + hs + 1) / 24.0f);
    const float c1 = 0.125f * 1.4426950408889634f, c2 = slope * (float)d * 1.4426950408889634f;
    const size_t qrow = (size_t)b * SEQ + (size_t)(l0 + r32) * d + res;
    bf16x8 qf[4];
#pragma unroll
    for (int kk = 0; kk < 4; ++kk) qf[kk] = *(const bf16x8*)(AQKV + qrow * NATT + qcol + kk * 16 + hi * 8);
#pragma unroll
    for (int r = 0; r < 16; ++r) { o0[r] = 0.f; o1[r] = 0.f; }
    m_run = -1e30f; l_run = 0.f;
    const int lq = l0 + r32;
#pragma unroll 1
    for (int kt = 0; kt < 5; ++kt) {
        const int k0 = l0 - 128 + 32 * kt;
        if (k0 < 0) continue;
        const size_t krow = (size_t)b * SEQ + (size_t)(k0 + r32) * d + res;
        bf16x8 kf[4];
#pragma unroll
        for (int kk = 0; kk < 4; ++kk) kf[kk] = *(const bf16x8*)(AQKV + krow * NATT + kcol + kk * 16 + hi * 8);
#pragma unroll
        for (int i = 0; i < 4; ++i) {
            const int key = (lane >> 3) + 8 * i, cc = lane & 7;
            const size_t vrow = (size_t)b * SEQ + (size_t)(k0 + key) * d + res;
            const v4u w = *(const v4u*)(AQKV + vrow * NATT + vcol + cc * 8);
            *(LAS v4u*)(vst + (cc >> 2) * 2048 + key * 64 + (cc & 3) * 16) = w;
        }
        f32x16 s;
#pragma unroll
        for (int r = 0; r < 16; ++r) s[r] = 0.f;
#pragma unroll
        for (int kk = 0; kk < 4; ++kk) s = __builtin_amdgcn_mfma_f32_32x32x16_bf16(kf[kk], qf[kk], s, 0, 0, 0);
        float tmax = -1e30f;
#pragma unroll
        for (int r = 0; r < 16; ++r) {
            const int keyi = (r & 3) + 8 * (r >> 2) + 4 * hi;
            const int delta = lq - (k0 + keyi);
            const float t = s[r] * c1 - c2 * (float)delta;
            s[r] = (delta >= 0 && delta <= 128) ? t : -1e30f;
            tmax = fmaxf(tmax, s[r]);
        }
        tmax = fmaxf(tmax, __shfl_xor(tmax, 32));
        const float m_new = fmaxf(m_run, tmax);
        const float corr = __builtin_amdgcn_exp2f(m_run - m_new);
        float psum = 0.f;
#pragma unroll
        for (int r = 0; r < 16; ++r) { s[r] = __builtin_amdgcn_exp2f(s[r] - m_new); psum += s[r]; }
        psum += __shfl_xor(psum, 32);
        l_run = l_run * corr + psum; m_run = m_new;
#pragma unroll
        for (int r = 0; r < 16; ++r) { o0[r] *= corr; o1[r] *= corr; }
        bf16x8 pf[2];
#pragma unroll
        for (int si = 0; si < 2; ++si) {
            v4u w; w.x = cvtpk(s[8 * si + 0], s[8 * si + 1]); w.y = cvtpk(s[8 * si + 2], s[8 * si + 3]); w.z = cvtpk(s[8 * si + 4], s[8 * si + 5]); w.w = cvtpk(s[8 * si + 6], s[8 * si + 7]);
            pf[si] = __builtin_bit_cast(bf16x8, w);
        }
#pragma unroll
        for (int si = 0; si < 2; ++si) {
            const LAS unsigned char* vb = vst + (16 * si + 4 * hi + ((lane & 15) >> 2)) * 64 + ((lane >> 4) & 1) * 32 + (lane & 3) * 8;
            const s16x4 a0 = lds_tr(vb), a1 = lds_tr(vb + 512), b0 = lds_tr(vb + 2048), b1 = lds_tr(vb + 2048 + 512);
            const bf16x8 vf0 = (bf16x8){a0[0], a0[1], a0[2], a0[3], a1[0], a1[1], a1[2], a1[3]};
            const bf16x8 vf1 = (bf16x8){b0[0], b0[1], b0[2], b0[3], b1[0], b1[1], b1[2], b1[3]};
            o0 = __builtin_amdgcn_mfma_f32_32x32x16_bf16(vf0, pf[si], o0, 0, 0, 0);
            o1 = __builtin_amdgcn_mfma_f32_32x32x16_bf16(vf1, pf[si], o1, 0, 0, 0);
        }
    }
}

__device__ __forceinline__ void attn_phase(const bf16* AQKV, bf16* YB, bf16* O2S, float* LSE, LAS unsigned char* lds, int vcu, int G, int wave, int lane) {
    LAS unsigned char* vst = lds + wave * 4096;
    const int r32 = lane & 31, hi = lane >> 5;
    for (int u = vcu; u < 256; u += G) {
        const int b = u >> 5, hs = (u >> 2) & 7, P0 = (u & 3) * 512;
#pragma unroll 1
        for (int i = 0; i < 4; ++i) {
            const int ta = wave + 8 * i, g = ta >> 4, ti = ta & 15;
            const int d = g == 0 ? 1 : 4, tpr = 16 / d, res = ti / tpr, l0 = P0 / d + 32 * (ti % tpr);
            f32x16 o0, o1; float m_run, l_run;
            attn_tile(AQKV, b, hs, g, d, res, l0, vst, lane, o0, o1, m_run, l_run);
            const size_t row = (size_t)b * SEQ + (size_t)(l0 + r32) * d + res;
            const float inv = 1.0f / l_run;
            bf16* dst = (g == 0 ? YB : O2S) + row * 512 + hs * 64 + 4 * hi;
#pragma unroll
            for (int q = 0; q < 4; ++q) {
                v2u w0; w0.x = cvtpk(o0[4 * q] * inv, o0[4 * q + 1] * inv); w0.y = cvtpk(o0[4 * q + 2] * inv, o0[4 * q + 3] * inv);
                v2u w1; w1.x = cvtpk(o1[4 * q] * inv, o1[4 * q + 1] * inv); w1.y = cvtpk(o1[4 * q + 2] * inv, o1[4 * q + 3] * inv);
                *(v2u*)(dst + 8 * q) = w0; *(v2u*)(dst + 32 + 8 * q) = w1;
            }
            if (hi == 0) LSE[(size_t)g * (M * 8) + row * 8 + hs] = m_run + __log2f(l_run);
        }
        asm volatile("s_waitcnt vmcnt(0)" ::: "memory");
        __syncthreads();
#pragma unroll 1
        for (int i = 0; i < 2; ++i) {
            const int res = wave + 8 * i, l0 = P0 / 16;
            f32x16 o0, o1; float m_run, l_run;
            attn_tile(AQKV, b, hs, 2, 16, res, l0, vst, lane, o0, o1, m_run, l_run);
            const size_t row = (size_t)b * SEQ + (size_t)(l0 + r32) * 16 + res;
            const float e3 = m_run + __log2f(l_run);
            const float e1 = __uint_as_float(__hip_atomic_load((const unsigned*)(LSE + row * 8 + hs), RLX_AGENT));
            const float e2 = __uint_as_float(__hip_atomic_load((const unsigned*)(LSE + (size_t)(M * 8) + row * 8 + hs), RLX_AGENT));
            const float mx = fmaxf(fmaxf(e1, e2), e3);
            const float w1 = __builtin_amdgcn_exp2f(e1 - mx), w2 = __builtin_amdgcn_exp2f(e2 - mx), w3 = __builtin_amdgcn_exp2f(e3 - mx);
            const float iw = 1.0f / (w1 + w2 + w3);
            const float a1 = w1 * iw, a2 = w2 * iw, a3 = w3 * iw / l_run;
            const size_t off = row * 512 + hs * 64 + 4 * hi;
#pragma unroll
            for (int q = 0; q < 4; ++q) {
#pragma unroll
                for (int dh = 0; dh < 2; ++dh) {
                    const unsigned long long x1 = __hip_atomic_load((const unsigned long long*)(YB + off + 32 * dh + 8 * q), RLX_AGENT);
                    const unsigned long long x2 = __hip_atomic_load((const unsigned long long*)(O2S + off + 32 * dh + 8 * q), RLX_AGENT);
                    const unsigned x1l = (unsigned)x1, x1h = (unsigned)(x1 >> 32), x2l = (unsigned)x2, x2h = (unsigned)(x2 >> 32);
                    const float v0 = (dh ? o1[4 * q] : o0[4 * q]), v1 = (dh ? o1[4 * q + 1] : o0[4 * q + 1]), v2 = (dh ? o1[4 * q + 2] : o0[4 * q + 2]), v3 = (dh ? o1[4 * q + 3] : o0[4 * q + 3]);
                    const float y0 = a1 * __uint_as_float(x1l << 16) + a2 * __uint_as_float(x2l << 16) + a3 * v0;
                    const float y1 = a1 * __uint_as_float(x1l & 0xffff0000u) + a2 * __uint_as_float(x2l & 0xffff0000u) + a3 * v1;
                    const float y2 = a1 * __uint_as_float(x1h << 16) + a2 * __uint_as_float(x2h << 16) + a3 * v2;
                    const float y3 = a1 * __uint_as_float(x1h & 0xffff0000u) + a2 * __uint_as_float(x2h & 0xffff0000u) + a3 * v3;
                    v2u w; w.x = cvtpk(y0, y1); w.y = cvtpk(y2, y3);
                    *(v2u*)(YB + off + 32 * dh + 8 * q) = w;
                }
            }
        }
        asm volatile("s_waitcnt vmcnt(0)" ::: "memory");
        __syncthreads();
    }
}

namespace hg {
constexpr int IST = 272, PST = 144;
constexpr int OFF_QI = 0, OFF_KI = 64 * IST, OFF_KH = 2 * 64 * IST, OFF_VI = 3 * 64 * IST, OFF_PI = 4 * 64 * IST, OFF_PT = OFF_PI + 64 * PST, OFF_DEC = OFF_PT + 2048, OFF_RS = OFF_DEC + 512, OFF_END = OFF_RS + 2048;
static_assert(OFF_END <= RING_BYTES && OFF_PT % 16 == 0 && OFF_RS % 16 == 0, "hgrn LDS map");
typedef short v4i16_t __attribute__((ext_vector_type(4)));
typedef short s16x4 __attribute__((ext_vector_type(4)));
typedef unsigned v2u __attribute__((ext_vector_type(2)));
__device__ __forceinline__ s16x4 tr(const LAS unsigned char* p) { return __builtin_bit_cast(s16x4, __builtin_amdgcn_ds_read_tr16_b64_v4i16((LAS v4i16_t*)p)); }
__device__ __forceinline__ bf16x8 tr8(const LAS unsigned char* p, int second) { const s16x4 a = tr(p), b = tr(p + second); return (bf16x8){a[0], a[1], a[2], a[3], b[0], b[1], b[2], b[3]}; }
__device__ __forceinline__ unsigned cvtpk(float lo, float hi) { unsigned r; asm volatile("v_cvt_pk_bf16_f32 %0, %1, %2" : "=v"(r) : "v"(lo), "v"(hi)); return r; }

template <bool FULL> __device__ __forceinline__ void prep(const bf16* HQ, size_t row0, int h, float lbk, LAS unsigned char* L, int tid, float& dlog) {
    const int k = tid & 127, part = tid >> 7;
    LAS float* PT = (LAS float*)(L + OFF_PT);
    float cs[16], kk[16], qv[16];
#pragma unroll
    for (int i = 0; i < 16; ++i) {
        const size_t row = row0 + 16 * part + i;
        const float fp = bf2f(HQ[row * 2048 + 512 + h * 128 + k]);
        const float e = __expf(-fp), sg = 1.0f / (1.0f + e);
        const float f = lbk + (1.0f - lbk) * sg;
        kk[i] = (1.0f - lbk) * (e * sg);
        cs[i] = __logf(f);
        if (FULL) qv[i] = bf2f(HQ[row * 2048 + h * 128 + k]);
    }
#pragma unroll
    for (int i = 1; i < 16; ++i) cs[i] += cs[i - 1];
    PT[part * 128 + k] = cs[15];
    __syncthreads();
    const float p0 = PT[k], p1 = PT[128 + k], p2 = PT[256 + k], p3 = PT[384 + k];
    const float off = (part > 0 ? p0 : 0.f) + (part > 1 ? p1 : 0.f) + (part > 2 ? p2 : 0.f), tot = (p0 + p1) + (p2 + p3);
#pragma unroll
    for (int i = 0; i < 16; ++i) {
        const float Gt = off + cs[i]; const int t = 16 * part + i;
        if (FULL) {
            *(LAS bf16*)(L + OFF_QI + t * IST + k * 2) = (bf16)f2bf(qv[i] * __expf(Gt));
            *(LAS bf16*)(L + OFF_KI + t * IST + k * 2) = (bf16)f2bf(kk[i] * __expf(-Gt));
        }
        *(LAS bf16*)(L + OFF_KH + t * IST + k * 2) = (bf16)f2bf(kk[i] * __expf(tot - Gt));
    }
    if (part == 0) { ((LAS float*)(L + OFF_DEC))[k] = __expf(tot); dlog += tot; }
#pragma unroll
    for (int j = 0; j < 2; ++j) {
        const int c = tid + 512 * j, t = c >> 4, cc = c & 15;
        const v4u w = *(const v4u*)(HQ + (row0 + t) * 2048 + 1024 + h * 128 + cc * 8);
        *(LAS v4u*)(L + OFF_VI + t * IST + cc * 16) = w;
    }
    __syncthreads();
}
__device__ __forceinline__ void scores(LAS unsigned char* L, int wave, int lane) {
    const int fr = lane & 15, quad = lane >> 4;
#pragma unroll
    for (int e = 0; e < 2; ++e) {
        const int id = wave * 2 + e, ti = id >> 2, si = id & 3;
        f32x4 acc = (f32x4){0.f, 0.f, 0.f, 0.f};
        if (si <= ti) {
#pragma unroll
            for (int st = 0; st < 4; ++st) {
                const bf16x8 a = *(const LAS bf16x8*)(L + OFF_QI + (16 * ti + fr) * IST + (32 * st + 8 * quad) * 2);
                const bf16x8 b = *(const LAS bf16x8*)(L + OFF_KI + (16 * si + fr) * IST + (32 * st + 8 * quad) * 2);
                acc = __builtin_amdgcn_mfma_f32_16x16x32_bf16(a, b, acc, 0, 0, 0);
            }
        }
#pragma unroll
        for (int r = 0; r < 4; ++r) {
            const int t = 16 * ti + 4 * quad + r, s = 16 * si + fr;
            const float v = (s <= t) ? acc[r] : 0.f;
            *(LAS bf16*)(L + OFF_PI + t * PST + s * 2) = (bf16)f2bf(v);
        }
    }
}
template <bool FULL> __device__ __forceinline__ void mainstep(LAS unsigned char* L, int wave, int lane, f32x4 (&S)[8], f32x4 (&o)[4], bool update) {
    const int fr = lane & 15, quad = lane >> 4, q4 = fr >> 2, p = fr & 3;
    bf16x8 vf[2];
#pragma unroll
    for (int ss = 0; ss < 2; ++ss) vf[ss] = tr8(L + OFF_VI + (32 * ss + 8 * quad + q4) * IST + (16 * wave + 4 * p) * 2, 4 * IST);
    if (FULL) {
#pragma unroll
        for (int tt = 0; tt < 4; ++tt) {
            o[tt] = (f32x4){0.f, 0.f, 0.f, 0.f};
#pragma unroll
            for (int ss = 0; ss < 2; ++ss) {
                const bf16x8 a = *(const LAS bf16x8*)(L + OFF_PI + (16 * tt + fr) * PST + (32 * ss + 8 * quad) * 2);
                o[tt] = __builtin_amdgcn_mfma_f32_16x16x32_bf16(a, vf[ss], o[tt], 0, 0, 0);
            }
        }
#pragma unroll
        for (int ks = 0; ks < 4; ++ks) {
            v4u sw; sw.x = cvtpk(S[2 * ks][0], S[2 * ks][1]); sw.y = cvtpk(S[2 * ks][2], S[2 * ks][3]); sw.z = cvtpk(S[2 * ks + 1][0], S[2 * ks + 1][1]); sw.w = cvtpk(S[2 * ks + 1][2], S[2 * ks + 1][3]);
            const bf16x8 sf = __builtin_bit_cast(bf16x8, sw);
#pragma unroll
            for (int tt = 0; tt < 4; ++tt) {
                const LAS unsigned char* qa = L + OFF_QI + (16 * tt + fr) * IST + (32 * ks + 4 * quad) * 2;
                const v2u lo = *(const LAS v2u*)qa, hi = *(const LAS v2u*)(qa + 32);
                const v4u aw = (v4u){lo.x, lo.y, hi.x, hi.y};
                o[tt] = __builtin_amdgcn_mfma_f32_16x16x32_bf16(__builtin_bit_cast(bf16x8, aw), sf, o[tt], 0, 0, 0);
            }
        }
    }
    if (update) {
#pragma unroll
        for (int kt = 0; kt < 8; ++kt) {
            const f32x4 dc = *(const LAS f32x4*)(L + OFF_DEC + (16 * kt + 4 * quad) * 4);
            f32x4 c = S[kt] * dc;
#pragma unroll
            for (int ts = 0; ts < 2; ++ts) {
                const bf16x8 a = tr8(L + OFF_KH + (32 * ts + 8 * quad + q4) * IST + (16 * kt + 4 * p) * 2, 4 * IST);
                c = __builtin_amdgcn_mfma_f32_16x16x32_bf16(a, vf[ts], c, 0, 0, 0);
            }
            S[kt] = c;
        }
    }
}
__device__ __forceinline__ void pass1(const bf16* HQ, const float* lbraw, float* LST, float* DLG, LAS unsigned char* L, int vcu, int G, int tid, int wave, int lane) {
    const int fr = lane & 15, quad = lane >> 4;
    for (int u = vcu; u < 256; u += G) {
        const int b = u >> 5, h = (u >> 3) & 3, sc = u & 7;
        const int k = tid & 127;
        const float lbk = 1.0f / (1.0f + __expf(lbraw[512 + h * 128 + k] - lbraw[h * 128 + k]));
        f32x4 S[8], o[4];
#pragma unroll
        for (int kt = 0; kt < 8; ++kt) S[kt] = (f32x4){0.f, 0.f, 0.f, 0.f};
        float dlog = 0.f;
#pragma unroll 1
        for (int sub = 0; sub < 4; ++sub) {
            prep<false>(HQ, (size_t)b * SEQ + sc * 256 + sub * 64, h, lbk, L, tid, dlog);
            mainstep<false>(L, wave, lane, S, o, true);
        }
#pragma unroll
        for (int kt = 0; kt < 8; ++kt)
#pragma unroll
            for (int r = 0; r < 4; ++r) LST[((size_t)u * 128 + 16 * kt + 4 * quad + r) * 128 + 16 * wave + fr] = S[kt][r];
        if (tid < 128) DLG[u * 128 + tid] = dlog;
        __syncthreads();
    }
}
__device__ __forceinline__ void pass2(const bf16* HQ, const float* lbraw, const float* onorm, const float* LST, const float* DLG, bf16* YA, LAS unsigned char* L, int vcu, int G, int tid, int wave, int lane) {
    const int fr = lane & 15, quad = lane >> 4;
    LAS float* RS = (LAS float*)(L + OFF_RS);
    for (int u = vcu; u < 256; u += G) {
        const int b = u >> 5, h = (u >> 3) & 3, sc = u & 7;
        const int k = tid & 127;
        const float lbk = 1.0f / (1.0f + __expf(lbraw[512 + h * 128 + k] - lbraw[h * 128 + k]));
        const float gain = onorm[h * 128 + 16 * wave + fr];
        f32x4 S[8], o[4];
#pragma unroll
        for (int kt = 0; kt < 8; ++kt) S[kt] = (f32x4){0.f, 0.f, 0.f, 0.f};
#pragma unroll 1
        for (int j = 0; j < sc; ++j) {
            const int uj = (u & ~7) + j;
#pragma unroll
            for (int kt = 0; kt < 8; ++kt) {
                const f32x4 dl = *(const f32x4*)(DLG + uj * 128 + 16 * kt + 4 * quad);
#pragma unroll
                for (int r = 0; r < 4; ++r) S[kt][r] = __expf(dl[r]) * S[kt][r] + LST[((size_t)uj * 128 + 16 * kt + 4 * quad + r) * 128 + 16 * wave + fr];
            }
        }
        float dlog = 0.f;
#pragma unroll 1
        for (int sub = 0; sub < 4; ++sub) {
            const size_t row0 = (size_t)b * SEQ + sc * 256 + sub * 64;
            prep<true>(HQ, row0, h, lbk, L, tid, dlog);
            scores(L, wave, lane);
            __syncthreads();
            mainstep<true>(L, wave, lane, S, o, sub < 3);
#pragma unroll
            for (int tt = 0; tt < 4; ++tt)
#pragma unroll
                for (int r = 0; r < 4; ++r) {
                    float sq = o[tt][r] * o[tt][r];
                    sq += __shfl_xor(sq, 1); sq += __shfl_xor(sq, 2); sq += __shfl_xor(sq, 4); sq += __shfl_xor(sq, 8);
                    if (fr == 0) RS[(16 * tt + 4 * quad + r) * 8 + wave] = sq;
                }
            __syncthreads();
#pragma unroll
            for (int tt = 0; tt < 4; ++tt)
#pragma unroll
                for (int r = 0; r < 4; ++r) {
                    const int t = 16 * tt + 4 * quad + r;
                    const f32x4 r0 = *(const LAS f32x4*)(RS + t * 8), r1 = *(const LAS f32x4*)(RS + t * 8 + 4);
                    const float tot = ((r0[0] + r0[1]) + (r0[2] + r0[3])) + ((r1[0] + r1[1]) + (r1[2] + r1[3]));
                    const float rs = rsqrtf(tot * (1.0f / 128.0f) + EPS);
                    const size_t row = row0 + t;
                    const float og = bf2f(HQ[row * 2048 + 1536 + h * 128 + 16 * wave + fr]);
                    const float y = o[tt][r] * rs * gain * (og / (1.0f + __expf(-og)));
                    YA[row * 512 + h * 128 + 16 * wave + fr] = (bf16)f2bf(y);
                }
        }
        __syncthreads();
    }
}
}

struct Args { const float* in[15]; float* out; unsigned char* ws; int ph_lo, ph_hi, li, pad; };
__global__ void __launch_bounds__(NWAVES * 64, 2) mk_fwd(Args args) {
    __shared__ __attribute__((aligned(16))) unsigned char lds_raw[LDS_BYTES];
    LAS unsigned char* lds = (LAS unsigned char*)lds_raw;
    volatile LAS unsigned* MISC = (volatile LAS unsigned*)(lds + MISC_OFF);
    const int tid = threadIdx.x, lane = tid & 63, wave = __builtin_amdgcn_readfirstlane(tid >> 6);
    const int G = gridDim.x; const int bx = blockIdx.x; const int vcu = (G % 8 == 0) ? (bx % 8) * (G / 8) + bx / 8 : bx;
    const int gw = vcu * NWAVES + wave, NGW = G * NWAVES;
    unsigned char* ws = args.ws;
    gu32* ctl = (gu32*)(ws + WS_CTL);
    const float* x = args.in[0]; const float* ffn1_norm = args.in[1]; const float* ffn1_wgu = args.in[2]; const float* ffn1_wd = args.in[3]; const float* mix_norm = args.in[4];
    const float* w_in = args.in[5]; const float* hg_lb = args.in[6]; const float* hg_onorm = args.in[7]; const float* w_bhg = args.in[8]; const float* w_batt = args.in[9];
    const float* w_out = args.in[10]; const float* ffn2_norm = args.in[11]; const float* ffn2_wgu = args.in[12]; const float* ffn2_wd = args.in[13]; const float* final_norm = args.in[14];
    float* out = args.out;
    float* SS = (float*)(ws + WS_SS);
    bf16* WGU1 = (bf16*)(ws + WS_WGU1); bf16* WD1 = (bf16*)(ws + WS_WD1); bf16* WGU2 = (bf16*)(ws + WS_WGU2); bf16* WD2 = (bf16*)(ws + WS_WD2);
    bf16* WIN = (bf16*)(ws + WS_WIN); bf16* WA = (bf16*)(ws + WS_WA); bf16* WB = (bf16*)(ws + WS_WB); bf16* WO = (bf16*)(ws + WS_WO);
    bf16* HB = (bf16*)(ws + WS_HB); bf16* HID = (bf16*)(ws + WS_HID); bf16* AQKV = (bf16*)(ws + WS_AQKV); bf16* YB = (bf16*)(ws + WS_YB);
    bf16* HQ = (bf16*)(ws + WS_HQ); bf16* GATES = (bf16*)(ws + WS_GATES); bf16* YA = (bf16*)(ws + WS_YA); bf16* TMP = (bf16*)(ws + WS_TMP); bf16* MERGED = (bf16*)(ws + WS_MERGED);

    for (int u = tid; u < (LDS_BYTES - LDSCTL_OFF) / 4; u += NWAVES * 64) ((LAS unsigned*)(lds + LDSCTL_OFF))[u] = 0u;
    __syncthreads();
    XcdBarrier bar; bar.bar = (unsigned*)(ctl + CW_BAR); bar.x = 0; bar.st = nullptr;
    if (N_LAUNCHES == 1) bar = xcd_barrier_post((unsigned*)(ctl + CW_BAR), MISC + 8);
    const int lo = args.ph_lo, hi = args.ph_hi;
#define IN(k) (lo <= (k) && (k) < hi)
#define SEAM(k) do { if (IN(k) && IN((k) + 1)) xcd_barrier(bar); } while (0)

    if (IN(0)) {
        LAS float* scr = (LAS float*)(lds + RING_OFF + wave * 16384);
        constexpr int I_GU = (D / 64) * (NGU / 32), I_DN = (FF / 64) * (D / 32), I_IN = (D / 64) * (NIN / 32), I_BR = (512 / 64) * (D / 32), I_WO = (D / 64) * (D / 32);
        constexpr int NITEMS = 2 * I_GU + 2 * I_DN + I_IN + 2 * I_BR + I_WO;
        for (int it = gw; it < NITEMS; it += NGW) {
            int r = it;
            if (r < I_GU) { p0_transpose_item(ffn1_wgu, ffn1_norm, D, NGU, WGU1, 1, scr, r, lane); continue; } r -= I_GU;
            if (r < I_GU) { p0_transpose_item(ffn2_wgu, ffn2_norm, D, NGU, WGU2, 1, scr, r, lane); continue; } r -= I_GU;
            if (r < I_DN) { p0_transpose_item(ffn1_wd, nullptr, FF, D, WD1, 0, scr, r, lane); continue; } r -= I_DN;
            if (r < I_DN) { p0_transpose_item(ffn2_wd, nullptr, FF, D, WD2, 0, scr, r, lane); continue; } r -= I_DN;
            if (r < I_IN) { p0_transpose_item(w_in, mix_norm, D, NIN, WIN, 2, scr, r, lane); continue; } r -= I_IN;
            if (r < I_BR) { p0_transpose_item(w_bhg, nullptr, 512, D, WA, 0, scr, r, lane); continue; } r -= I_BR;
            if (r < I_BR) { p0_transpose_item(w_batt, nullptr, 512, D, WB, 0, scr, r, lane); continue; } r -= I_BR;
            p0_transpose_item(w_out, nullptr, D, D, WO, 0, scr, r, lane);
        }
        for (int m = gw; m < M; m += NGW) {
            const GAS f32x4* xr = (const GAS f32x4*)(x + (size_t)m * D) + lane;
            f32x4 v[4]; float s = 0.f;
#pragma unroll
            for (int j = 0; j < 4; ++j) { v[j] = xr[64 * j]; s += (v[j].x * v[j].x + v[j].y * v[j].y) + (v[j].z * v[j].z + v[j].w * v[j].w); }
            s = wave_sum(s);
            if (lane == 0) SS[m] = s;
            GAS unsigned long long* o8 = (GAS unsigned long long*)(HB + (size_t)m * D) + lane;
#pragma unroll
            for (int j = 0; j < 4; ++j) o8[64 * j] = (unsigned long long)pk2(v[j].x, v[j].y) | ((unsigned long long)pk2(v[j].z, v[j].w) << 32);
        }
        for (int i = vcu * (NWAVES * 64) + tid; i < 3 * M; i += G * NWAVES * 64) SS[M + i] = 0.f;
    }
    SEAM(0);
    if (IN(1)) {
        pg8::Gemm g{HB, WGU1, HB, WGU1, D}; pg8::StaticOrder S; S.init(M, NGU, G, bx);
        pg8::EpiSwiGLU E{HID, SS, FF};
        pg8::gemm_phase<pg8::EpiSwiGLU, pg8::StaticOrder, true, true>(lds + RING_OFF, g, S, E);
    }
    SEAM(1);
    if (IN(2)) {
        pg8::Gemm g{HID, WD1, HID, WD1, FF}; pg8::StaticOrder S; S.init(M, D, G, bx);
        pg8::EpiResid E{x, out, HB, SS + M, 0.5f};
        pg8::gemm_phase<pg8::EpiResid, pg8::StaticOrder, true, true>(lds + RING_OFF, g, S, E);
    }
    SEAM(2);
    if (IN(3)) {
        pg8::Gemm g{HB, WIN + (size_t)4096 * D, HB, WIN + (size_t)4096 * D, D}; pg8::StaticOrder S; S.init(M, NATT, G, bx);
        pg8::EpiProj E{AQKV, NATT, AQKV, NATT, 1 << 30, SS + M};
        pg8::gemm_phase<pg8::EpiProj, pg8::StaticOrder, true, true>(lds + RING_OFF, g, S, E);
    }
    SEAM(3);
    if (IN(4)) {
#if ATTN_NAIVE
        attn_naive(AQKV, YB, (LAS float*)(lds + RING_OFF) + wave * 64, gw, NGW, lane);
#else
        attn_phase(AQKV, YB, (bf16*)(ws + WS_O2S), (float*)(ws + WS_LSE), lds + RING_OFF, vcu, G, wave, lane);
#endif
    }
    SEAM(4);
    if (IN(5)) {
        pg8::Gemm g{HB, WIN, HB, WIN, D}; pg8::StaticOrder S; S.init(M, NHG + NGATE, G, bx);
        pg8::EpiProj E{HQ, NHG, GATES, NGATE, NHG / 256, SS + M};
        pg8::gemm_phase<pg8::EpiProj, pg8::StaticOrder, true, true>(lds + RING_OFF, g, S, E);
    }
    SEAM(5);
#if HGRN_NAIVE
    if (IN(6)) { hgrn_naive(HQ, hg_lb, hg_onorm, YA, lds + RING_OFF, tid); }
    SEAM(6);
    SEAM(7);
#else
    if (IN(6)) { hg::pass1(HQ, hg_lb, (float*)(ws + WS_LST), (float*)(ws + WS_DLG), lds + RING_OFF, vcu, G, tid, wave, lane); }
    SEAM(6);
    if (IN(7)) { hg::pass2(HQ, hg_lb, hg_onorm, (const float*)(ws + WS_LST), (const float*)(ws + WS_DLG), YA, lds + RING_OFF, vcu, G, tid, wave, lane); }
    SEAM(7);
#endif
    if (IN(8)) {
        pg8::Gemm g{YA, WA, YB, WB, 512}; pg8::MergeOrder S; S.init(M, D, G, bx);
        pg8::EpiMerge E{GATES, TMP, MERGED};
        pg8::gemm_phase<pg8::EpiMerge, pg8::MergeOrder, true, true>(lds + RING_OFF, g, S, E);
    }
    SEAM(8);
    if (IN(9)) {
        pg8::Gemm g{MERGED, WO, MERGED, WO, D}; pg8::StaticOrder S; S.init(M, D, G, bx);
        pg8::EpiResid E{out, out, HB, SS + 2 * M, 1.0f};
        pg8::gemm_phase<pg8::EpiResid, pg8::StaticOrder, true, true>(lds + RING_OFF, g, S, E);
    }
    SEAM(9);
    if (IN(10)) {
        pg8::Gemm g{HB, WGU2, HB, WGU2, D}; pg8::StaticOrder S; S.init(M, NGU, G, bx);
        pg8::EpiSwiGLU E{HID, SS + 2 * M, FF};
        pg8::gemm_phase<pg8::EpiSwiGLU, pg8::StaticOrder, true, true>(lds + RING_OFF, g, S, E);
    }
    SEAM(10);
    if (IN(11)) {
        pg8::Gemm g{HID, WD2, HID, WD2, FF}; pg8::StaticOrder S; S.init(M, D, G, bx);
        pg8::EpiResid E{out, out, HB, SS + 3 * M, 0.5f};
        pg8::gemm_phase<pg8::EpiResid, pg8::StaticOrder, true, true>(lds + RING_OFF, g, S, E);
    }
    SEAM(11);
    if (IN(12)) {
        for (int m = gw; m < M; m += NGW) {
            GAS f32x4* r = (GAS f32x4*)(out + (size_t)m * D) + lane; const GAS f32x4* gn = (const GAS f32x4*)final_norm + lane;
            const float rs = rsqrtf(SS[3 * M + m] * (1.0f / D) + EPS);
#pragma unroll
            for (int j = 0; j < 4; ++j) { f32x4 v = r[64 * j]; v = v * rs * gn[64 * j]; r[64 * j] = v; }
        }
    }
#undef IN
#undef SEAM
}

extern "C" void kernel_launch(void* const* d_in, const int* in_sizes, int n_in, void* d_out, int out_size, void* d_ws, size_t ws_size, hipStream_t stream) {
    static int grid = 0;
    if (grid == 0) {
        if (n_in != 15 || out_size != M * D || ws_size < WS_END) { fprintf(stderr, "kernel_launch: unexpected shapes (n_in %d out %d ws %zu)\n", n_in, out_size, ws_size); grid = -1; return; }
        int dev = 0, cus = 0;
        if (hipGetDevice(&dev) != hipSuccess || hipDeviceGetAttribute(&cus, hipDeviceAttributeMultiprocessorCount, dev) != hipSuccess) { grid = -1; return; }
        grid = cus;
    }
    if (grid < 0) return;
    if (hipMemsetAsync((char*)d_ws + WS_CTL, 0, CTL_ZERO_BYTES, stream) != hipSuccess) return;
    Args a{};
    for (int i = 0; i < 15; ++i) a.in[i] = (const float*)d_in[i];
    a.out = (float*)d_out; a.ws = (unsigned char*)d_ws;
    for (int li = 0; li < N_LAUNCHES; ++li) {
        a.ph_lo = (N_LAUNCHES == 1) ? 0 : li; a.ph_hi = (N_LAUNCHES == 1) ? N_PHASES : li + 1; a.li = li;
        hipLaunchKernelGGL(mk_fwd, dim3(grid), dim3(NWAVES * 64), 0, stream, a);
    }
}
```

```cpp
#include <hip/hip_runtime.h>
#include <cstdio>
#include <cstdint>
namespace pg8 {
#define PG8_LAS __attribute__((address_space(3)))
typedef unsigned short bf16_t;
typedef short bf16x8 __attribute__((ext_vector_type(8)));
typedef float f32x4 __attribute__((ext_vector_type(4)));
typedef unsigned u32x4 __attribute__((ext_vector_type(4)));
constexpr int BM = 256, BK = 64, HALF = 128, HTB = HALF * BK * 2  , STAGE_BYTES = 8 * HTB, NXCD = 8, WGM = 8;

__host__ __device__ __forceinline__ int lds_byte(int r, int c) { const int st = (r >> 4) * 2 + (c >> 5), rr = r & 15, cc = c & 31, ob = rr * 64 + cc * 2; return st * 1024 + (ob ^ (((ob >> 9) & 1) << 5)); }
__host__ __device__ __forceinline__ void stage_rc(int b, int& R, int& C) { const int st = b / 1024, sb = b % 1024, swz = sb ^ (((sb >> 9) & 1) << 5); R = (st >> 1) * 16 + swz / 64; C = (st & 1) * 32 + (swz % 64) / 2; }
__host__ __device__ __forceinline__ int perm32(int rho) { const int n = rho >> 4, i = rho & 15; return 8 * (i >> 2) + 4 * n + (i & 3); }

struct Unit { int pm, pn, z; };
struct Gemm { const bf16_t* A; const bf16_t* Bt; const bf16_t* A1; const bf16_t* Bt1; int K; };

struct StaticOrder {
    int nM, nN, nwg, G, c;
    __host__ __device__ void init(int M, int N, int G_, int c_) { nM = M / BM; nN = N / BM; nwg = nM * nN; G = G_; c = c_; }
    __host__ __device__ bool next(int i, Unit& u) const {
        const long L = (long)i * G + c; if (L >= nwg) return false;
        int wgid = (int)L; { const int q = nwg / NXCD, r = nwg % NXCD, xcd = wgid % NXCD, off = wgid / NXCD; wgid = (xcd < r ? xcd * (q + 1) : r * (q + 1) + (xcd - r) * q) + off; }
        const int nig = WGM * nN, gid = wgid / nig, fm = gid * WGM, gsz = (nM - fm) < WGM ? (nM - fm) : WGM;
        u.pm = fm + ((wgid % nig) % gsz); u.pn = (wgid % nig) / gsz; u.z = 0; return true;
    }
    __device__ __forceinline__ void a_ready(const Unit&) const {}
    __device__ __forceinline__ void done(const Unit&) const {}
};


__device__ __forceinline__ unsigned cvt_pk_bf16(float lo, float hi) { unsigned r; asm volatile("v_cvt_pk_bf16_f32 %0, %1, %2" : "=v"(r) : "v"(lo), "v"(hi)); return r; }
typedef float f32x2 __attribute__((ext_vector_type(2)));
__device__ __forceinline__ float fast_sigmoid(float x) { return __builtin_amdgcn_rcpf(1.0f + __builtin_amdgcn_exp2f(-1.4426950408889634f * x)); }
__device__ __forceinline__ float bf_lo(unsigned w) { return __uint_as_float(w << 16); }
__device__ __forceinline__ float bf_hi(unsigned w) { return __uint_as_float(w & 0xffff0000u); }
__device__ __forceinline__ float row_rstd(const float* ss, int row) { return rsqrtf(ss[row] * (1.0f / 1024.0f) + 1e-6f); }
__device__ __forceinline__ u32x4 pack8(const float (&h)[8]) { u32x4 w; w.x = cvt_pk_bf16(h[0], h[1]); w.y = cvt_pk_bf16(h[2], h[3]); w.z = cvt_pk_bf16(h[4], h[5]); w.w = cvt_pk_bf16(h[6], h[7]); return w; }

struct EpiSwiGLU {
    static constexpr bool PERM = true, AFTER_DRAIN = false;
    bf16_t* O; const float* ss; int ldo;
    __device__ __forceinline__ void operator()(const f32x4 (&acc)[2][2][4][2], const Unit& u, int wr, int wc, int fr, int fq) const {
        const int row0 = u.pm * BM + wr * 64 + fr, col0 = u.pn * 128 + wc * 32 + 8 * fq;
#pragma unroll
        for (int ai = 0; ai < 2; ++ai)
#pragma unroll
            for (int m = 0; m < 4; ++m) {
                const int row = row0 + ai * HALF + m * 16; const float rs = row_rstd(ss, row);
                float h[8];
#pragma unroll
                for (int n = 0; n < 2; ++n)
#pragma unroll
                    for (int i = 0; i < 4; ++i) { const float g = acc[ai][0][m][n][i] * rs, up = acc[ai][1][m][n][i] * rs; h[4 * n + i] = g * fast_sigmoid(g) * up; }
                *(u32x4*)(O + (size_t)row * ldo + col0) = pack8(h);
            }
    }
};
struct EpiResid {
    static constexpr bool PERM = true, AFTER_DRAIN = false;
    const float* base; float* outf; bf16_t* hb; float* ss_out; float scale;
    __device__ __forceinline__ void operator()(const f32x4 (&acc)[2][2][4][2], const Unit& u, int wr, int wc, int fr, int fq) const {
        const int row0 = u.pm * BM + wr * 64 + fr;
#pragma unroll
        for (int ai = 0; ai < 2; ++ai)
#pragma unroll
            for (int m = 0; m < 4; ++m) {
                const int row = row0 + ai * HALF + m * 16; float ssq = 0.f;
#pragma unroll
                for (int bj = 0; bj < 2; ++bj) {
                    const size_t off = (size_t)row * 1024 + u.pn * BM + bj * HALF + wc * 32 + 8 * fq;
                    const f32x4 b0 = *(const f32x4*)(base + off), b1 = *(const f32x4*)(base + off + 4);
                    const f32x4 v0 = b0 + acc[ai][bj][m][0] * scale, v1 = b1 + acc[ai][bj][m][1] * scale;
                    *(f32x4*)(outf + off) = v0; *(f32x4*)(outf + off + 4) = v1;
                    const float h[8] = {v0[0], v0[1], v0[2], v0[3], v1[0], v1[1], v1[2], v1[3]};
                    *(u32x4*)(hb + off) = pack8(h);
#pragma unroll
                    for (int i = 0; i < 8; ++i) ssq += h[i] * h[i];
                }
                ssq += __shfl_xor(ssq, 16); ssq += __shfl_xor(ssq, 32);
                if (fq == 0) atomicAdd(ss_out + row, ssq);
            }
    }
};
struct EpiProj {
    static constexpr bool PERM = true, AFTER_DRAIN = false;
    bf16_t* o1; int ld1; bf16_t* o2; int ld2; int split_pn; const float* ss;
    __device__ __forceinline__ void operator()(const f32x4 (&acc)[2][2][4][2], const Unit& u, int wr, int wc, int fr, int fq) const {
        const int row0 = u.pm * BM + wr * 64 + fr; const bool second = u.pn >= split_pn;
        bf16_t* dst = second ? o2 : o1; const int ld = second ? ld2 : ld1; const int colt = (second ? u.pn - split_pn : u.pn) * BM + wc * 32 + 8 * fq;
#pragma unroll
        for (int ai = 0; ai < 2; ++ai)
#pragma unroll
            for (int m = 0; m < 4; ++m) {
                const int row = row0 + ai * HALF + m * 16; const float rs = row_rstd(ss, row);
#pragma unroll
                for (int bj = 0; bj < 2; ++bj) {
                    float h[8];
#pragma unroll
                    for (int n = 0; n < 2; ++n)
#pragma unroll
                        for (int i = 0; i < 4; ++i) { const float v = acc[ai][bj][m][n][i] * rs; h[4 * n + i] = second ? fast_sigmoid(v) : v; }
                    *(u32x4*)(dst + (size_t)row * ld + colt + bj * HALF) = pack8(h);
                }
            }
    }
};
struct EpiMerge {
    static constexpr bool PERM = true, AFTER_DRAIN = false;
    const bf16_t* gates; bf16_t* tmp; bf16_t* merged;
    __device__ __forceinline__ void operator()(const f32x4 (&acc)[2][2][4][2], const Unit& u, int wr, int wc, int fr, int fq) const {
        const int row0 = u.pm * BM + wr * 64 + fr;
#pragma unroll
        for (int ai = 0; ai < 2; ++ai)
#pragma unroll
            for (int m = 0; m < 4; ++m) {
                const int row = row0 + ai * HALF + m * 16;
#pragma unroll
                for (int bj = 0; bj < 2; ++bj) {
                    const int col = u.pn * BM + bj * HALF + wc * 32 + 8 * fq;
                    const u32x4 gw = *(const u32x4*)(gates + (size_t)row * 2048 + u.z * 1024 + col);
                    const float gt[8] = {bf_lo(gw.x), bf_hi(gw.x), bf_lo(gw.y), bf_hi(gw.y), bf_lo(gw.z), bf_hi(gw.z), bf_lo(gw.w), bf_hi(gw.w)};
                    float h[8];
#pragma unroll
                    for (int n = 0; n < 2; ++n)
#pragma unroll
                        for (int i = 0; i < 4; ++i) h[4 * n + i] = acc[ai][bj][m][n][i] * gt[4 * n + i];
                    if (u.z) {
                        const u32x4 tw = *(const u32x4*)(tmp + (size_t)row * 1024 + col);
                        h[0] += bf_lo(tw.x); h[1] += bf_hi(tw.x); h[2] += bf_lo(tw.y); h[3] += bf_hi(tw.y); h[4] += bf_lo(tw.z); h[5] += bf_hi(tw.z); h[6] += bf_lo(tw.w); h[7] += bf_hi(tw.w);
                        *(u32x4*)(merged + (size_t)row * 1024 + col) = pack8(h);
                    } else *(u32x4*)(tmp + (size_t)row * 1024 + col) = pack8(h);
                }
            }
    }
};
struct MergeOrder : StaticOrder {
    __host__ __device__ bool next(int i, Unit& u) const { if (!StaticOrder::next(i >> 1, u)) return false; u.z = i & 1; return true; }
};

template <class Epi, class Sched, bool ALIGN_EPI = false, bool SP2 = false>
__device__ __forceinline__ void gemm_phase(PG8_LAS unsigned char* lds, const Gemm g, const Sched& S, const Epi& E) {
    const int tid = threadIdx.x, wid = __builtin_amdgcn_readfirstlane(tid >> 6), lane = tid & 63, wr = wid >> 2, wc = wid & 3, fr = lane & 15, fq = lane >> 4;
    const int K = g.K, nt = K / BK;
    unsigned voffA[2], voffB[2];
#pragma unroll
    for (int i = 0; i < 2; ++i) { int R, C; stage_rc(tid * 16 + i * 8192, R, C); const int Rb = Epi::PERM ? ((R & ~31) + perm32(R & 31)) : R;
        voffA[i] = (unsigned)(R * K + C) * 2u; voffB[i] = (unsigned)(Rb * K + C) * 2u; }
    const size_t kstep = (size_t)(BK * 2);
    const size_t hstep = (size_t)HALF * K * 2;
    const size_t tstep = 2 * hstep;
    const unsigned ldsw = (unsigned)wid * 1024u;
    const int aoff = lds_byte(wr * 64 + fr, fq * 8), boff = lds_byte(wc * 32 + fr, fq * 8);
#define PG8_SA(b, h) (((b) * 2 + (h)) * HTB)
#define PG8_SB(b, h) ((4 + (b) * 2 + (h)) * HTB)
#define PG8_STAGE(bufoff, gbase, voff) do { _Pragma("unroll") for (int _i = 0; _i < 2; ++_i) \
        __builtin_amdgcn_global_load_lds((const unsigned*)((const char*)(gbase) + (voff)[_i]), (PG8_LAS unsigned*)(lds + (bufoff) + ldsw + _i * 8192), 16, 0, 0); } while (0)
#define PG8_LDA(dst, b, h) do { _Pragma("unroll") for (int m = 0; m < 4; ++m) _Pragma("unroll") for (int k = 0; k < 2; ++k) dst[m][k] = *(const PG8_LAS bf16x8*)(lds + PG8_SA(b, h) + aoff + m * 2048 + k * 1024); } while (0)
#define PG8_LDB(dst, b, h) do { _Pragma("unroll") for (int n = 0; n < 2; ++n) _Pragma("unroll") for (int k = 0; k < 2; ++k) dst[n][k] = *(const PG8_LAS bf16x8*)(lds + PG8_SB(b, h) + boff + n * 2048 + k * 1024); } while (0)
#define PG8_MMA(ai, bj, At, Bt) do { __builtin_amdgcn_s_setprio(1); _Pragma("unroll") for (int m = 0; m < 4; ++m) _Pragma("unroll") for (int n = 0; n < 2; ++n) _Pragma("unroll") for (int k = 0; k < 2; ++k) \
        acc[ai][bj][m][n] = __builtin_amdgcn_mfma_f32_16x16x32_bf16(Bt[n][k], At[m][k], acc[ai][bj][m][n], 0, 0, 0); __builtin_amdgcn_s_setprio(0); } while (0)
#define PG8_WAIT_V(n) asm volatile("s_waitcnt vmcnt(" #n ")" ::: "memory")
#define PG8_WAIT_L(n) asm volatile("s_waitcnt lgkmcnt(" #n ")" ::: "memory")
#define PG8_BAR __builtin_amdgcn_s_barrier()
#define PG8_SCHED __builtin_amdgcn_sched_barrier(0)
    Unit cur, nxt; int ui = 0;
    if (!S.next(0, cur)) return;
    f32x4 acc[2][2][4][2];
#pragma unroll
    for (int a = 0; a < 2; ++a)
#pragma unroll
        for (int b = 0; b < 2; ++b)
#pragma unroll
            for (int m = 0; m < 4; ++m)
#pragma unroll
                for (int n = 0; n < 2; ++n) acc[a][b][m][n] = (f32x4){0.f, 0.f, 0.f, 0.f};
    bf16x8 At[4][2], B0[2][2], B1[2][2];
    const char* cA = (const char*)(cur.z ? g.A1 : g.A) + (size_t)cur.pm * tstep; const char* cB = (const char*)(cur.z ? g.Bt1 : g.Bt) + (size_t)cur.pn * tstep;
    S.a_ready(cur);
    if constexpr (SP2) {
        PG8_STAGE(PG8_SB(0, 0), cB, voffB); PG8_STAGE(PG8_SB(0, 1), cB + hstep, voffB); PG8_STAGE(PG8_SA(0, 0), cA, voffA); PG8_STAGE(PG8_SA(0, 1), cA + hstep, voffA);
        if (wr == 1) PG8_BAR;
        PG8_WAIT_V(2); PG8_BAR;
        PG8_STAGE(PG8_SB(1, 0), cB + kstep, voffB); PG8_STAGE(PG8_SA(1, 0), cA + kstep, voffA); PG8_STAGE(PG8_SB(1, 1), cB + hstep + kstep, voffB);
        PG8_WAIT_V(6); PG8_BAR;
    } else {
        PG8_STAGE(PG8_SB(0, 0), cB, voffB); PG8_STAGE(PG8_SA(0, 0), cA, voffA); PG8_STAGE(PG8_SB(0, 1), cB + hstep, voffB); PG8_STAGE(PG8_SA(0, 1), cA + hstep, voffA);
        if (wr == 1) PG8_BAR;
        PG8_WAIT_V(4); PG8_BAR;
        PG8_STAGE(PG8_SB(1, 0), cB + kstep, voffB); PG8_STAGE(PG8_SA(1, 0), cA + kstep, voffA); PG8_STAGE(PG8_SB(1, 1), cB + hstep + kstep, voffB);
        PG8_WAIT_V(6); PG8_BAR;
    }
    for (;;) {
        const bool has_next = S.next(ui + 1, nxt);
        const char* nA = has_next ? (const char*)(nxt.z ? g.A1 : g.A) + (size_t)nxt.pm * tstep : cA; const char* nB = has_next ? (const char*)(nxt.z ? g.Bt1 : g.Bt) + (size_t)nxt.pn * tstep : cB;
        for (int t = 0; t < nt; t += 2) {
            const bool last = (t == nt - 2);
            const char* a1 = cA + (size_t)(t + 1) * kstep;
            const char* a2 = last ? nA : cA + (size_t)(t + 2) * kstep; const char* b2 = last ? nB : cB + (size_t)(t + 2) * kstep;
            const char* a3 = a2 + kstep; const char* b3 = b2 + kstep;
            if (last && has_next) S.a_ready(nxt);
            if constexpr (SP2) {
            PG8_LDB(B0, 0, 0); PG8_LDB(B1, 0, 1); PG8_SCHED; PG8_LDA(At, 0, 0); PG8_STAGE(PG8_SA(1, 1), a1 + hstep, voffA);
            PG8_WAIT_V(8); PG8_WAIT_L(0); PG8_BAR; PG8_MMA(0, 0, At, B0); PG8_MMA(0, 1, At, B1); PG8_BAR; PG8_SCHED;
            PG8_LDA(At, 0, 1); PG8_STAGE(PG8_SB(0, 0), b2, voffB); PG8_STAGE(PG8_SB(0, 1), b2 + hstep, voffB); PG8_STAGE(PG8_SA(0, 0), a2, voffA);
            PG8_WAIT_V(8); PG8_WAIT_L(0); PG8_BAR; PG8_MMA(1, 0, At, B0); PG8_MMA(1, 1, At, B1); PG8_BAR; PG8_SCHED;
            PG8_LDB(B0, 1, 0); PG8_LDB(B1, 1, 1); PG8_SCHED; PG8_LDA(At, 1, 0); PG8_STAGE(PG8_SA(0, 1), a2 + hstep, voffA);
            PG8_WAIT_V(8); PG8_WAIT_L(0); PG8_BAR; PG8_MMA(0, 0, At, B0); PG8_MMA(0, 1, At, B1); PG8_BAR; PG8_SCHED;
            PG8_LDA(At, 1, 1); PG8_STAGE(PG8_SB(1, 0), b3, voffB); PG8_STAGE(PG8_SB(1, 1), b3 + hstep, voffB); PG8_STAGE(PG8_SA(1, 0), a3, voffA);
            PG8_WAIT_V(8); PG8_WAIT_L(0); PG8_BAR; PG8_MMA(1, 0, At, B0); PG8_MMA(1, 1, At, B1); PG8_BAR; PG8_SCHED;
            } else {
            PG8_LDB(B0, 0, 0); PG8_SCHED; PG8_LDA(At, 0, 0); PG8_STAGE(PG8_SA(1, 1), a1 + hstep, voffA);
            PG8_WAIT_L(8); PG8_BAR; PG8_WAIT_L(0); PG8_MMA(0, 0, At, B0); PG8_BAR; PG8_SCHED;
            PG8_LDB(B1, 0, 1); PG8_STAGE(PG8_SB(0, 0), b2, voffB);
            PG8_BAR; PG8_WAIT_L(0); PG8_MMA(0, 1, At, B1); PG8_BAR;
            PG8_LDA(At, 0, 1); PG8_STAGE(PG8_SA(0, 0), a2, voffA);
            PG8_BAR; PG8_WAIT_L(0); PG8_MMA(1, 0, At, B0); PG8_BAR; PG8_SCHED;
            PG8_STAGE(PG8_SB(0, 1), b2 + hstep, voffB);
            PG8_WAIT_V(6); PG8_BAR; PG8_MMA(1, 1, At, B1); PG8_BAR;
            PG8_LDB(B0, 1, 0); PG8_SCHED; PG8_LDA(At, 1, 0); PG8_STAGE(PG8_SA(0, 1), a2 + hstep, voffA);
            PG8_WAIT_L(8); PG8_BAR; PG8_WAIT_L(0); PG8_MMA(0, 0, At, B0); PG8_BAR; PG8_SCHED;
            PG8_LDB(B1, 1, 1); PG8_STAGE(PG8_SB(1, 0), b3, voffB);
            PG8_BAR; PG8_WAIT_L(0); PG8_MMA(0, 1, At, B1); PG8_BAR;
            PG8_LDA(At, 1, 1); PG8_STAGE(PG8_SA(1, 0), a3, voffA);
            PG8_BAR; PG8_WAIT_L(0); PG8_MMA(1, 0, At, B0); PG8_BAR; PG8_SCHED;
            PG8_STAGE(PG8_SB(1, 1), b3 + hstep, voffB);
            PG8_WAIT_V(6); PG8_BAR; PG8_MMA(1, 1, At, B1); PG8_BAR;
            }
        }
        if constexpr (ALIGN_EPI) { if (wr == 0) PG8_BAR; }
        if constexpr (!Epi::AFTER_DRAIN) { E(acc, cur, wr, wc, fr, fq); S.done(cur); }
        if (!has_next) break;
#pragma unroll
        for (int a = 0; a < 2; ++a)
#pragma unroll
            for (int b = 0; b < 2; ++b)
#pragma unroll
                for (int m = 0; m < 4; ++m)
#pragma unroll
                    for (int n = 0; n < 2; ++n) acc[a][b][m][n] = (f32x4){0.f, 0.f, 0.f, 0.f};
        cur = nxt; cA = nA; cB = nB; ++ui;
        if constexpr (ALIGN_EPI) { if (wr == 1) PG8_BAR; }
    }
    PG8_WAIT_V(0);
    if constexpr (!ALIGN_EPI) { if (wr == 0) PG8_BAR; }
    PG8_BAR;
    if constexpr (Epi::AFTER_DRAIN) { E.fused(acc, cur, wr, wc, fr, fq, lds, wid, lane); S.done(cur); }
#undef PG8_SA
#undef PG8_SB
#undef PG8_STAGE
#undef PG8_LDA
#undef PG8_LDB
#undef PG8_MMA
#undef PG8_WAIT_V
#undef PG8_WAIT_L
#undef PG8_BAR
#undef PG8_SCHED
}
}

#define GAS __attribute__((address_space(1)))
#define LAS __attribute__((address_space(3)))
typedef unsigned short bf16;
typedef unsigned v4u __attribute__((ext_vector_type(4)));
typedef float f32x4 __attribute__((ext_vector_type(4)));
typedef short bf16x8 __attribute__((ext_vector_type(8)));
typedef GAS unsigned gu32;
typedef GAS unsigned long long gu64;
#define RLX_AGENT __ATOMIC_RELAXED, __HIP_MEMORY_SCOPE_AGENT
#define LDS_WAIT() asm volatile("s_waitcnt lgkmcnt(0)" ::: "memory")
#define VM_WAIT() asm volatile("s_waitcnt vmcnt(0)" ::: "memory")
__device__ __forceinline__ unsigned long long rt() { return __builtin_amdgcn_s_memrealtime(); }
__device__ __forceinline__ unsigned f2bf(float f) { unsigned u = __builtin_bit_cast(unsigned, f); return (u + 0x7fffu + ((u >> 16) & 1u)) >> 16; }
__device__ __forceinline__ unsigned pk2(float lo, float hi) { return f2bf(lo) | (f2bf(hi) << 16); }
#define XB_TMO      128
#define XB_XCNT(j)  (256  + 64 * (j))
#define XB_XSUB(j)  (1280 + 64 * (j))
#define XB_XGEN(j)  (2304 + 64 * (j))
#define XB_TOP      3328
#define XB_TOPGEN   3392
#define XCD_BAR_WORDS 3456
#define XB_SPIN_CAP (1u << 18)

__device__ __forceinline__ unsigned xb_ld(unsigned* p)              { return __hip_atomic_load(p, __ATOMIC_RELAXED, __HIP_MEMORY_SCOPE_AGENT); }
__device__ __forceinline__ unsigned xb_add(unsigned* p, unsigned v) { return __hip_atomic_fetch_add(p, v, __ATOMIC_RELAXED, __HIP_MEMORY_SCOPE_AGENT); }
__device__ __forceinline__ unsigned xb_xcc_id() { return (unsigned)__builtin_amdgcn_s_getreg((3 << 11) | 20) & 0xFu; }
#define XB_SPIN(cond, bar) do { unsigned _sp = 0; while (cond) { __builtin_amdgcn_s_sleep(1); \
    if ((++_sp & 255u) == 0u) { if (xb_ld(&(bar)[XB_TMO])) break; if (_sp > XB_SPIN_CAP) { atomicAdd(&(bar)[XB_TMO], 1u); break; } } } } while (0)

struct XcdBarrier {
    unsigned* bar; unsigned x;
    volatile LAS unsigned* st;
};

__device__ __forceinline__ XcdBarrier xcd_barrier_post(unsigned* bar, volatile LAS unsigned* st) {
    XcdBarrier b; b.bar = bar; b.x = xb_xcc_id(); b.st = st;
    if (threadIdx.x == 0) (void)xb_add(&bar[XB_XCNT(b.x)], 1u);
    return b;
}
__device__ __forceinline__ void xcd_barrier_complete(unsigned* bar, unsigned x, unsigned& nloc, unsigned& nx) {
    const unsigned G = gridDim.x * gridDim.y * gridDim.z;
    unsigned sum, cnt, mine, sp = 0u;
    for (;;) {
        sum = 0u; cnt = 0u; mine = 0u;
#pragma unroll
        for (unsigned j = 0; j < 16; ++j) { const unsigned c = xb_ld(&bar[XB_XCNT(j)]); sum += c; cnt += (c > 0u) ? 1u : 0u; mine = (j == x) ? c : mine; }
        if (sum == G) break;
        __builtin_amdgcn_s_sleep(1);
        if ((++sp & 255u) == 0u) { if (xb_ld(&bar[XB_TMO])) break; if (sp > XB_SPIN_CAP) { atomicAdd(&bar[XB_TMO], 1u); break; } }
    }
    nloc = mine > 0u ? mine : 1u; nx = cnt > 0u ? cnt : 1u;
}

__device__ __forceinline__ void xcd_barrier(const XcdBarrier& b) {
    asm volatile("s_waitcnt vmcnt(0)" ::: "memory");
    __syncthreads();
    if (threadIdx.x == 0) {
        unsigned* bar = b.bar;
        __builtin_amdgcn_s_waitcnt(0);
        unsigned nloc = b.st[0], nx = b.st[1];
        if (nloc == 0u) { xcd_barrier_complete(bar, b.x, nloc, nx); b.st[0] = nloc; b.st[1] = nx; }
        const unsigned old = xb_add(&bar[XB_XSUB(b.x)], 1u);
        const unsigned gen = old / nloc;
        if (old + 1u == (gen + 1u) * nloc) {
            __builtin_amdgcn_fence(__ATOMIC_RELEASE, "agent");
            asm volatile("s_waitcnt vmcnt(0)" ::: "memory");
            const unsigned og = xb_add(&bar[XB_TOP], 1u);
            const unsigned tg = og / nx;
            if (og + 1u == (tg + 1u) * nx) xb_add(&bar[XB_TOPGEN], 1u);
            else XB_SPIN(xb_ld(&bar[XB_TOPGEN]) == tg, bar);
            __builtin_amdgcn_fence(__ATOMIC_ACQUIRE, "agent");
            xb_add(&bar[XB_XGEN(b.x)], 1u);
            asm volatile("s_waitcnt vmcnt(0)" ::: "memory");
        } else {
            XB_SPIN(xb_ld(&bar[XB_XGEN(b.x)]) == gen, bar);
            __builtin_amdgcn_fence(__ATOMIC_ACQUIRE, "agent");
            asm volatile("s_waitcnt vmcnt(0)" ::: "memory");
        }
    }
    __syncthreads();
}

constexpr int NWAVES = 8;
#ifndef PROBE_REPEAT
#define PROBE_REPEAT -1
#endif
#ifndef HGRN_NAIVE
#define HGRN_NAIVE 0
#endif
#ifndef ATTN_NAIVE
#define ATTN_NAIVE 0
#endif
#ifndef MK_N_LAUNCHES
#define MK_N_LAUNCHES 1
#endif
constexpr int N_PHASES = 13;
constexpr int N_LAUNCHES = MK_N_LAUNCHES;

constexpr int M = 16384, SEQ = 2048, D = 1024, FF = 2816, NGU = 2 * FF, NIN = 8704, NATT = 4608, NHG = 2048, NGATE = 2048;
constexpr float EPS = 1e-6f;

constexpr size_t MiB = 1u << 20;
constexpr size_t WS_CTL = 0, CTL_ZERO_BYTES = 1 * MiB;
constexpr size_t WS_SS = 1 * MiB;
constexpr size_t WS_WGU1 = 2 * MiB, WS_WD1 = 13 * MiB, WS_WGU2 = 18 * MiB + 512 * 1024, WS_WD2 = 29 * MiB + 512 * 1024, WS_WIN = 35 * MiB, WS_WA = 52 * MiB, WS_WB = 53 * MiB, WS_WO = 54 * MiB;
constexpr size_t WS_HB = 56 * MiB;
constexpr size_t WS_BIG = 88 * MiB;
constexpr size_t WS_HID = WS_BIG;
constexpr size_t WS_AQKV = WS_BIG, WS_YB = 232 * MiB;
constexpr size_t WS_HQ = WS_BIG, WS_GATES = 152 * MiB, WS_YA = 216 * MiB;
constexpr size_t WS_TMP = WS_BIG, WS_MERGED = 120 * MiB;
constexpr size_t WS_O2S = 2 * MiB, WS_LSE = 248 * MiB;
constexpr size_t WS_LST = 2 * MiB, WS_DLG = 249 * MiB;
constexpr size_t WS_END = 256 * MiB;
static_assert(WS_WGU1 + (size_t)NGU * D * 2 <= WS_WD1 && WS_WD1 + (size_t)D * FF * 2 <= WS_WGU2 && WS_WGU2 + (size_t)NGU * D * 2 <= WS_WD2 && WS_WD2 + (size_t)D * FF * 2 <= WS_WIN && WS_WIN + (size_t)NIN * D * 2 <= WS_WA, "ws map: weights");
static_assert(WS_HB + (size_t)M * D * 2 <= WS_BIG && WS_HID + (size_t)M * FF * 2 <= WS_END && WS_AQKV + (size_t)M * NATT * 2 <= WS_YB && WS_YB + (size_t)M * 512 * 2 <= WS_END, "ws map: acts");
static_assert(WS_HQ + (size_t)M * NHG * 2 <= WS_GATES && WS_GATES + (size_t)M * NGATE * 2 <= WS_YA && WS_YA + (size_t)M * 512 * 2 <= WS_YB && WS_TMP + (size_t)M * D * 2 <= WS_MERGED && WS_MERGED + (size_t)M * D * 2 <= WS_GATES, "ws map: mixer");
constexpr int CW_BAR = 4096;

constexpr int RING_OFF = 0, RING_BYTES = 131072;
constexpr int LDSCTL_OFF = RING_BYTES, MISC_OFF = LDSCTL_OFF + 320;
constexpr int LDS_BYTES = 147456;

__device__ __forceinline__ float bf2f(bf16 x) { return __uint_as_float((unsigned)x << 16); }
__device__ __forceinline__ float wave_sum(float v) {
#pragma unroll
    for (int o = 1; o < 64; o <<= 1) v += __shfl_xor(v, o);
    return v;
}
__device__ __forceinline__ float wave_max(float v) {
#pragma unroll
    for (int o = 1; o < 64; o <<= 1) v = fmaxf(v, __shfl_xor(v, o));
    return v;
}
__device__ __forceinline__ float sigmoidf_(float x) { return 1.0f / (1.0f + __expf(-x)); }

__device__ __forceinline__ void p0_transpose_item(const float* W, const float* gain, int K, int N, bf16* WT, int mapmode, LAS float* scr, int item, int lane) {
    const int nblk = N / 32, kb = item / nblk, nb = item % nblk, k0 = 64 * kb, n0 = 32 * nb;
    int d0;
    if (mapmode == 1) { const int bj = n0 >= FF ? 1 : 0, c = n0 - bj * FF; d0 = (c >> 7) * 256 + bj * 128 + (c & 127); }
    else if (mapmode == 2) { d0 = n0 < 2048 ? n0 : (n0 < 6656 ? 4096 + (n0 - 2048) : 2048 + (n0 - 6656)); }
    else d0 = n0;
#pragma unroll
    for (int i = 0; i < 8; ++i) { const int kk = 8 * i + (lane >> 3), c4 = 4 * (lane & 7); const float g = gain ? gain[k0 + kk] : 1.0f;
        const f32x4 w = *(const GAS f32x4*)(W + (size_t)(k0 + kk) * N + n0 + c4);
        scr[kk * 33 + c4] = w.x * g; scr[kk * 33 + c4 + 1] = w.y * g; scr[kk * 33 + c4 + 2] = w.z * g; scr[kk * 33 + c4 + 3] = w.w * g; }
    LDS_WAIT(); asm volatile("" ::: "memory");
    const int c = lane & 7;
#pragma unroll
    for (int j = 0; j < 4; ++j) { const int n = (lane >> 3) + 8 * j; const LAS float* s = scr + (8 * c) * 33 + n;
        v4u o; o.x = pk2(s[0 * 33], s[1 * 33]); o.y = pk2(s[2 * 33], s[3 * 33]); o.z = pk2(s[4 * 33], s[5 * 33]); o.w = pk2(s[6 * 33], s[7 * 33]);
        *(GAS v4u*)(WT + (size_t)(d0 + n) * K + k0 + 8 * c) = o; }
    LDS_WAIT(); asm volatile("" ::: "memory");
}

__device__ __forceinline__ void hgrn_naive(const bf16* HQ, const float* lbraw, const float* onorm, bf16* YA, LAS unsigned char* lds, int tid) {
    if (blockIdx.x >= 16) return;
    constexpr int TB = 8;
    LAS f32x4* L4 = (LAS f32x4*)lds;
    LAS float* OB = (LAS float*)(lds + 2 * TB * 128 * 16);
    LAS float* WSUM = OB + 2 * TB * 2 * 128;
    const int cw = tid >> 8, kh = (tid >> 7) & 1, v = tid & 127, lane = tid & 63, wv = (tid >> 6) & 1;
    const int chain = blockIdx.x * 2 + cw, b = chain >> 2, h = chain & 3;
    const float a0 = lbraw[h * 128 + v], a1 = lbraw[512 + h * 128 + v];
    const float lb = 1.0f / (1.0f + __expf(a1 - a0));
    const float gain = onorm[h * 128 + v];
    float S[64];
#pragma unroll
    for (int k = 0; k < 64; ++k) S[k] = 0.f;
    for (int t0 = 0; t0 < SEQ; t0 += TB) {
#pragma unroll 1
        for (int tt = kh; tt < TB; tt += 2) {
            const size_t row = (size_t)b * SEQ + t0 + tt;
            const float qv = bf2f(HQ[row * 2048 + h * 128 + v]), fp = bf2f(HQ[row * 2048 + 512 + h * 128 + v]);
            const float f = lb + (1.0f - lb) * sigmoidf_(fp);
            L4[(cw * TB + tt) * 128 + v] = (f32x4){qv, f, 1.0f - f, 0.f};
        }
        __syncthreads();
#pragma unroll 1
        for (int tt = 0; tt < TB; ++tt) {
            const size_t row = (size_t)b * SEQ + t0 + tt;
            const float iv = bf2f(HQ[row * 2048 + 1024 + h * 128 + v]);
            float ot = 0.f;
#pragma unroll
            for (int kg = 0; kg < 8; ++kg) {
#pragma unroll
                for (int k8 = 0; k8 < 8; ++k8) { const int k = kg * 8 + k8; const f32x4 e = L4[(cw * TB + tt) * 128 + kh * 64 + k]; S[k] = e[1] * S[k] + e[2] * iv; ot += e[0] * S[k]; }
                __builtin_amdgcn_sched_barrier(0);
            }
            OB[((cw * TB + tt) * 2 + kh) * 128 + v] = ot;
        }
        __syncthreads();
        float o4[4];
#pragma unroll
        for (int i = 0; i < 4; ++i) {
            const int tt = 2 * i + kh;
            o4[i] = OB[((cw * TB + tt) * 2 + 0) * 128 + v] + OB[((cw * TB + tt) * 2 + 1) * 128 + v];
            const float sq = wave_sum(o4[i] * o4[i]);
            if (lane == 0) WSUM[(cw * TB + tt) * 2 + wv] = sq;
        }
        __syncthreads();
#pragma unroll
        for (int i = 0; i < 4; ++i) {
            const int tt = 2 * i + kh;
            const size_t row = (size_t)b * SEQ + t0 + tt;
            const float tot = WSUM[(cw * TB + tt) * 2] + WSUM[(cw * TB + tt) * 2 + 1];
            const float rs = rsqrtf(tot * (1.0f / 128.0f) + EPS);
            const float og = bf2f(HQ[row * 2048 + 1536 + h * 128 + v]);
            const float y = o4[i] * rs * gain * (og * sigmoidf_(og));
            YA[row * 512 + h * 128 + v] = (bf16)f2bf(y);
        }
        __syncthreads();
    }
}

__device__ __forceinline__ void attn_naive(const bf16* AQKV, bf16* YB, LAS float* wq, int gw, int NGW, int lane) {
    for (int unit = gw; unit < M * 8; unit += NGW) {
        const int row = unit >> 3, hs = unit & 7, b = row >> 11, s = row & (SEQ - 1);
        float m_run = -1e30f, l_run = 0.f, acc = 0.f;
#pragma unroll 1
        for (int g = 0; g < 3; ++g) {
            const int d = g == 0 ? 1 : (g == 1 ? 4 : 16);
            const float slope = exp2f(-8.0f * (float)(g * 8 + hs + 1) / 24.0f);
            const int qcol = g * 1536 + hs * 64, kcol = qcol + 512, vcol = qcol + 1024;
            wq[lane] = bf2f(AQKV[(size_t)row * NATT + qcol + lane]) * 0.125f;
            const int lq = s / d, nk = (lq < 128 ? lq : 128) + 1;
#pragma unroll 1
            for (int c0 = 0; c0 < nk; c0 += 64) {
                const int j = c0 + lane; const bool valid = j < nk;
                float sc = -1e30f;
                if (valid) {
                    const bf16* kr = AQKV + (size_t)(b * SEQ + s - j * d) * NATT + kcol;
                    float dot = 0.f;
#pragma unroll
                    for (int e8 = 0; e8 < 8; ++e8) {
                        const v4u w = *(const v4u*)(kr + e8 * 8);
                        dot += wq[e8 * 8 + 0] * __uint_as_float(w.x << 16) + wq[e8 * 8 + 1] * __uint_as_float(w.x & 0xffff0000u)
                             + wq[e8 * 8 + 2] * __uint_as_float(w.y << 16) + wq[e8 * 8 + 3] * __uint_as_float(w.y & 0xffff0000u)
                             + wq[e8 * 8 + 4] * __uint_as_float(w.z << 16) + wq[e8 * 8 + 5] * __uint_as_float(w.z & 0xffff0000u)
                             + wq[e8 * 8 + 6] * __uint_as_float(w.w << 16) + wq[e8 * 8 + 7] * __uint_as_float(w.w & 0xffff0000u);
                    }
                    sc = dot - slope * (float)(d * j);
                }
                const float m_new = fmaxf(m_run, wave_max(sc));
                const float p = valid ? __expf(sc - m_new) : 0.f;
                const float corr = __expf(m_run - m_new);
                l_run = l_run * corr + wave_sum(p); acc *= corr; m_run = m_new;
                const int cnt = (nk - c0) < 64 ? (nk - c0) : 64;
#pragma unroll 1
                for (int jj = 0; jj < cnt; ++jj) {
                    const float pj = __uint_as_float(__builtin_amdgcn_readlane(__float_as_uint(p), jj));
                    acc += pj * bf2f(AQKV[(size_t)(b * SEQ + s - (c0 + jj) * d) * NATT + vcol + lane]);
                }
            }
        }
        YB[(size_t)row * 512 + hs * 64 + lane] = (bf16)f2bf(acc / l_run);
    }
}

typedef float f32x16 __attribute__((ext_vector_type(16)));
typedef short s16x4 __attribute__((ext_vector_type(4)));
typedef short v4i16_t __attribute__((ext_vector_type(4)));
typedef unsigned v2u __attribute__((ext_vector_type(2)));
__device__ __forceinline__ s16x4 lds_tr(const LAS unsigned char* p) { return __builtin_bit_cast(s16x4, __builtin_amdgcn_ds_read_tr16_b64_v4i16((LAS v4i16_t*)p)); }
__device__ __forceinline__ unsigned cvtpk(float lo, float hi) { unsigned r; asm volatile("v_cvt_pk_bf16_f32 %0, %1, %2" : "=v"(r) : "v"(lo), "v"(hi)); return r; }

__device__ __forceinline__ void attn_tile(const bf16* AQKV, int b, int hs, int g, int d, int res, int l0, LAS unsigned char* vst, int lane,
                                          f32x16& o0, f32x16& o1, float& m_run, float& l_run) {
    const int r32 = lane & 31, hi = lane >> 5;
    const int qcol = g * 1536 + hs * 64, kcol = qcol + 512, vcol = qcol + 1024;
    const float slope = exp2f(-8.0f * (float)(g * 8 + hs + 1) / 24.0f);
    const float c1 = 0.125f * 1.4426950408889634f, c2 = slope * (float)d * 1.4426950408889634f;
    const size_t qrow = (size_t)b * SEQ + (size_t)(l0 + r32) * d + res;
    bf16x8 qf[4];
#pragma unroll
    for (int kk = 0; kk < 4; ++kk) qf[kk] = *(const bf16x8*)(AQKV + qrow * NATT + qcol + kk * 16 + hi * 8);
#pragma unroll
    for (int r = 0; r < 16; ++r) { o0[r] = 0.f; o1[r] = 0.f; }
    m_run = -1e30f; l_run = 0.f;
    const int lq = l0 + r32;
    const int kt0 = (l0 >= 128) ? 0 : 4 - (l0 >> 5);
    bf16x8 kn[4]; v4u vn[4];
    {
        const int k0 = l0 - 128 + 32 * kt0;
        const size_t krow = (size_t)b * SEQ + (size_t)(k0 + r32) * d + res;
#pragma unroll
        for (int kk = 0; kk < 4; ++kk) kn[kk] = *(const bf16x8*)(AQKV + krow * NATT + kcol + kk * 16 + hi * 8);
#pragma unroll
        for (int i = 0; i < 4; ++i) { const size_t vrow = (size_t)b * SEQ + (size_t)(k0 + (lane >> 3) + 8 * i) * d + res; vn[i] = *(const v4u*)(AQKV + vrow * NATT + vcol + (lane & 7) * 8); }
    }
#pragma unroll 1
    for (int kt = kt0; kt < 5; ++kt) {
        const int k0 = l0 - 128 + 32 * kt;
        bf16x8 kf[4];
#pragma unroll
        for (int kk = 0; kk < 4; ++kk) kf[kk] = kn[kk];
#pragma unroll
        for (int i = 0; i < 4; ++i) { const int key = (lane >> 3) + 8 * i, cc = lane & 7; *(LAS v4u*)(vst + (cc >> 2) * 2048 + key * 64 + (cc & 3) * 16) = vn[i]; }
        if (kt < 4) {
            const int k1 = k0 + 32;
            const size_t krow = (size_t)b * SEQ + (size_t)(k1 + r32) * d + res;
#pragma unroll
            for (int kk = 0; kk < 4; ++kk) kn[kk] = *(const bf16x8*)(AQKV + krow * NATT + kcol + kk * 16 + hi * 8);
#pragma unroll
            for (int i = 0; i < 4; ++i) { const size_t vrow = (size_t)b * SEQ + (size_t)(k1 + (lane >> 3) + 8 * i) * d + res; vn[i] = *(const v4u*)(AQKV + vrow * NATT + vcol + (lane & 7) * 8); }
        }
        f32x16 s;
#pragma unroll
        for (int r = 0; r < 16; ++r) s[r] = 0.f;
#pragma unroll
        for (int kk = 0; kk < 4; ++kk) s = __builtin_amdgcn_mfma_f32_32x32x16_bf16(kf[kk], qf[kk], s, 0, 0, 0);
        float tmax = -1e30f;
#pragma unroll
        for (int r = 0; r < 16; ++r) {
            const int keyi = (r & 3) + 8 * (r >> 2) + 4 * hi;
            const int delta = lq - (k0 + keyi);
            const float t = s[r] * c1 - c2 * (float)delta;
            s[r] = (delta >= 0 && delta <= 128) ? t : -1e30f;
            tmax = fmaxf(tmax, s[r]);
        }
        tmax = fmaxf(tmax, __shfl_xor(tmax, 32));
        const float m_new = fmaxf(m_run, tmax);
        const float corr = __builtin_amdgcn_exp2f(m_run - m_new);
        float psum = 0.f;
#pragma unroll
        for (int r = 0; r < 16; ++r) { s[r] = __builtin_amdgcn_exp2f(s[r] - m_new); psum += s[r]; }
        psum += __shfl_xor(psum, 32);
        l_run = l_run * corr + psum; m_run = m_new;
#pragma unroll
        for (int r = 0; r < 16; ++r) { o0[r] *= corr; o1[r] *= corr; }
        bf16x8 pf[2];
#pragma unroll
        for (int si = 0; si < 2; ++si) {
            v4u w; w.x = cvtpk(s[8 * si + 0], s[8 * si + 1]); w.y = cvtpk(s[8 * si + 2], s[8 * si + 3]); w.z = cvtpk(s[8 * si + 4], s[8 * si + 5]); w.w = cvtpk(s[8 * si + 6], s[8 * si + 7]);
            pf[si] = __builtin_bit_cast(bf16x8, w);
        }
#pragma unroll
        for (int si = 0; si < 2; ++si) {
            const LAS unsigned char* vb = vst + (16 * si + 4 * hi + ((lane & 15) >> 2)) * 64 + ((lane >> 4) & 1) * 32 + (lane & 3) * 8;
            const s16x4 a0 = lds_tr(vb), a1 = lds_tr(vb + 512), b0 = lds_tr(vb + 2048), b1 = lds_tr(vb + 2048 + 512);
            const bf16x8 vf0 = (bf16x8){a0[0], a0[1], a0[2], a0[3], a1[0], a1[1], a1[2], a1[3]};
            const bf16x8 vf1 = (bf16x8){b0[0], b0[1], b0[2], b0[3], b1[0], b1[1], b1[2], b1[3]};
            o0 = __builtin_amdgcn_mfma_f32_32x32x16_bf16(vf0, pf[si], o0, 0, 0, 0);
            o1 = __builtin_amdgcn_mfma_f32_32x32x16_bf16(vf1, pf[si], o1, 0, 0, 0);
        }
    }
}

__device__ __forceinline__ void attn_phase(const bf16* AQKV, bf16* YB, bf16* O2S, float* LSE, LAS unsigned char* lds, int vcu, int G, int wave, int lane) {
    LAS unsigned char* vst = lds + wave * 4096;
    const int r32 = lane & 31, hi = lane >> 5;
    for (int u = vcu; u < 256; u += G) {
        const int b = u >> 5, hs = (u >> 2) & 7, P0 = (u & 3) * 512;
#pragma unroll 1
        for (int i = 0; i < 4; ++i) {
            const int ta = wave + 8 * i, g = ta >> 4, ti = ta & 15;
            const int d = g == 0 ? 1 : 4, tpr = 16 / d, res = ti / tpr, l0 = P0 / d + 32 * (ti % tpr);
            f32x16 o0, o1; float m_run, l_run;
            attn_tile(AQKV, b, hs, g, d, res, l0, vst, lane, o0, o1, m_run, l_run);
            const size_t row = (size_t)b * SEQ + (size_t)(l0 + r32) * d + res;
            const float inv = 1.0f / l_run;
            bf16* dst = (g == 0 ? YB : O2S) + row * 512 + hs * 64 + 4 * hi;
#pragma unroll
            for (int q = 0; q < 4; ++q) {
                v2u w0; w0.x = cvtpk(o0[4 * q] * inv, o0[4 * q + 1] * inv); w0.y = cvtpk(o0[4 * q + 2] * inv, o0[4 * q + 3] * inv);
                v2u w1; w1.x = cvtpk(o1[4 * q] * inv, o1[4 * q + 1] * inv); w1.y = cvtpk(o1[4 * q + 2] * inv, o1[4 * q + 3] * inv);
                *(v2u*)(dst + 8 * q) = w0; *(v2u*)(dst + 32 + 8 * q) = w1;
            }
            if (hi == 0) LSE[(size_t)g * (M * 8) + row * 8 + hs] = m_run + __log2f(l_run);
        }
        asm volatile("s_waitcnt vmcnt(0)" ::: "memory");
        __syncthreads();
#pragma unroll 1
        for (int i = 0; i < 2; ++i) {
            const int res = wave + 8 * i, l0 = P0 / 16;
            f32x16 o0, o1; float m_run, l_run;
            attn_tile(AQKV, b, hs, 2, 16, res, l0, vst, lane, o0, o1, m_run, l_run);
            const size_t row = (size_t)b * SEQ + (size_t)(l0 + r32) * 16 + res;
            const float e3 = m_run + __log2f(l_run);
            const float e1 = __uint_as_float(__hip_atomic_load((const unsigned*)(LSE + row * 8 + hs), RLX_AGENT));
            const float e2 = __uint_as_float(__hip_atomic_load((const unsigned*)(LSE + (size_t)(M * 8) + row * 8 + hs), RLX_AGENT));
            const float mx = fmaxf(fmaxf(e1, e2), e3);
            const float w1 = __builtin_amdgcn_exp2f(e1 - mx), w2 = __builtin_amdgcn_exp2f(e2 - mx), w3 = __builtin_amdgcn_exp2f(e3 - mx);
            const float iw = 1.0f / (w1 + w2 + w3);
            const float a1 = w1 * iw, a2 = w2 * iw, a3 = w3 * iw / l_run;
            const size_t off = row * 512 + hs * 64 + 4 * hi;
#pragma unroll
            for (int q = 0; q < 4; ++q) {
#pragma unroll
                for (int dh = 0; dh < 2; ++dh) {
                    const unsigned long long x1 = __hip_atomic_load((const unsigned long long*)(YB + off + 32 * dh + 8 * q), RLX_AGENT);
                    const unsigned long long x2 = __hip_atomic_load((const unsigned long long*)(O2S + off + 32 * dh + 8 * q), RLX_AGENT);
                    const unsigned x1l = (unsigned)x1, x1h = (unsigned)(x1 >> 32), x2l = (unsigned)x2, x2h = (unsigned)(x2 >> 32);
                    const float v0 = (dh ? o1[4 * q] : o0[4 * q]), v1 = (dh ? o1[4 * q + 1] : o0[4 * q + 1]), v2 = (dh ? o1[4 * q + 2] : o0[4 * q + 2]), v3 = (dh ? o1[4 * q + 3] : o0[4 * q + 3]);
                    const float y0 = a1 * __uint_as_float(x1l << 16) + a2 * __uint_as_float(x2l << 16) + a3 * v0;
                    const float y1 = a1 * __uint_as_float(x1l & 0xffff0000u) + a2 * __uint_as_float(x2l & 0xffff0000u) + a3 * v1;
                    const float y2 = a1 * __uint_as_float(x1h << 16) + a2 * __uint_as_float(x2h << 16) + a3 * v2;
                    const float y3 = a1 * __uint_as_float(x1h & 0xffff0000u) + a2 * __uint_as_float(x2h & 0xffff0000u) + a3 * v3;
                    v2u w; w.x = cvtpk(y0, y1); w.y = cvtpk(y2, y3);
                    *(v2u*)(YB + off + 32 * dh + 8 * q) = w;
                }
            }
        }
        asm volatile("s_waitcnt vmcnt(0)" ::: "memory");
        __syncthreads();
    }
}

namespace hg {
constexpr int IST = 272, PST = 144;
constexpr int OFF_QI = 0, OFF_KI = 64 * IST, OFF_KH = 2 * 64 * IST, OFF_VI = 3 * 64 * IST, OFF_PI = 4 * 64 * IST, OFF_PT = OFF_PI + 64 * PST, OFF_DEC = OFF_PT + 2048, OFF_RS = OFF_DEC + 512, OFF_END = OFF_RS + 2048;
static_assert(OFF_END <= RING_BYTES && OFF_PT % 16 == 0 && OFF_RS % 16 == 0, "hgrn LDS map");
typedef short v4i16_t __attribute__((ext_vector_type(4)));
typedef short s16x4 __attribute__((ext_vector_type(4)));
typedef unsigned v2u __attribute__((ext_vector_type(2)));
__device__ __forceinline__ s16x4 tr(const LAS unsigned char* p) { return __builtin_bit_cast(s16x4, __builtin_amdgcn_ds_read_tr16_b64_v4i16((LAS v4i16_t*)p)); }
__device__ __forceinline__ bf16x8 tr8(const LAS unsigned char* p, int second) { const s16x4 a = tr(p), b = tr(p + second); return (bf16x8){a[0], a[1], a[2], a[3], b[0], b[1], b[2], b[3]}; }
__device__ __forceinline__ unsigned cvtpk(float lo, float hi) { unsigned r; asm volatile("v_cvt_pk_bf16_f32 %0, %1, %2" : "=v"(r) : "v"(lo), "v"(hi)); return r; }

template <bool FULL> __device__ __forceinline__ void prep(const bf16* HQ, size_t row0, int h, float lbk, LAS unsigned char* L, int tid, float& dlog) {
    const int k = tid & 127, part = tid >> 7;
    LAS float* PT = (LAS float*)(L + OFF_PT);
    float cs[16], kk[16], qv[16];
#pragma unroll
    for (int i = 0; i < 16; ++i) {
        const size_t row = row0 + 16 * part + i;
        const float fp = bf2f(HQ[row * 2048 + 512 + h * 128 + k]);
        const float e = __expf(-fp), sg = 1.0f / (1.0f + e);
        const float f = lbk + (1.0f - lbk) * sg;
        kk[i] = (1.0f - lbk) * (e * sg);
        cs[i] = __logf(f);
        if (FULL) qv[i] = bf2f(HQ[row * 2048 + h * 128 + k]);
    }
#pragma unroll
    for (int i = 1; i < 16; ++i) cs[i] += cs[i - 1];
    PT[part * 128 + k] = cs[15];
    __syncthreads();
    const float p0 = PT[k], p1 = PT[128 + k], p2 = PT[256 + k], p3 = PT[384 + k];
    const float off = (part > 0 ? p0 : 0.f) + (part > 1 ? p1 : 0.f) + (part > 2 ? p2 : 0.f), tot = (p0 + p1) + (p2 + p3);
#pragma unroll
    for (int i = 0; i < 16; ++i) {
        const float Gt = off + cs[i]; const int t = 16 * part + i;
        if (FULL) {
            *(LAS bf16*)(L + OFF_QI + t * IST + k * 2) = (bf16)f2bf(qv[i] * __expf(Gt));
            *(LAS bf16*)(L + OFF_KI + t * IST + k * 2) = (bf16)f2bf(kk[i] * __expf(-Gt));
        }
        *(LAS bf16*)(L + OFF_KH + t * IST + k * 2) = (bf16)f2bf(kk[i] * __expf(tot - Gt));
    }
    if (part == 0) { ((LAS float*)(L + OFF_DEC))[k] = __expf(tot); dlog += tot; }
#pragma unroll
    for (int j = 0; j < 2; ++j) {
        const int c = tid + 512 * j, t = c >> 4, cc = c & 15;
        const v4u w = *(const v4u*)(HQ + (row0 + t) * 2048 + 1024 + h * 128 + cc * 8);
        *(LAS v4u*)(L + OFF_VI + t * IST + cc * 16) = w;
    }
    __syncthreads();
}
__device__ __forceinline__ void scores(LAS unsigned char* L, int wave, int lane) {
    const int fr = lane & 15, quad = lane >> 4;
#pragma unroll
    for (int e = 0; e < 2; ++e) {
        const int id = wave * 2 + e, ti = id >> 2, si = id & 3;
        f32x4 acc = (f32x4){0.f, 0.f, 0.f, 0.f};
        if (si <= ti) {
#pragma unroll
            for (int st = 0; st < 4; ++st) {
                const bf16x8 a = *(const LAS bf16x8*)(L + OFF_QI + (16 * ti + fr) * IST + (32 * st + 8 * quad) * 2);
                const bf16x8 b = *(const LAS bf16x8*)(L + OFF_KI + (16 * si + fr) * IST + (32 * st + 8 * quad) * 2);
                acc = __builtin_amdgcn_mfma_f32_16x16x32_bf16(a, b, acc, 0, 0, 0);
            }
        }
#pragma unroll
        for (int r = 0; r < 4; ++r) {
            const int t = 16 * ti + 4 * quad + r, s = 16 * si + fr;
            const float v = (s <= t) ? acc[r] : 0.f;
            *(LAS bf16*)(L + OFF_PI + t * PST + s * 2) = (bf16)f2bf(v);
        }
    }
}
template <bool FULL> __device__ __forceinline__ void mainstep(LAS unsigned char* L, int wave, int lane, f32x4 (&S)[8], f32x4 (&o)[4], bool update) {
    const int fr = lane & 15, quad = lane >> 4, q4 = fr >> 2, p = fr & 3;
    bf16x8 vf[2];
#pragma unroll
    for (int ss = 0; ss < 2; ++ss) vf[ss] = tr8(L + OFF_VI + (32 * ss + 8 * quad + q4) * IST + (16 * wave + 4 * p) * 2, 4 * IST);
    if (FULL) {
#pragma unroll
        for (int tt = 0; tt < 4; ++tt) {
            o[tt] = (f32x4){0.f, 0.f, 0.f, 0.f};
#pragma unroll
            for (int ss = 0; ss < 2; ++ss) {
                const bf16x8 a = *(const LAS bf16x8*)(L + OFF_PI + (16 * tt + fr) * PST + (32 * ss + 8 * quad) * 2);
                o[tt] = __builtin_amdgcn_mfma_f32_16x16x32_bf16(a, vf[ss], o[tt], 0, 0, 0);
            }
        }
#pragma unroll
        for (int ks = 0; ks < 4; ++ks) {
            v4u sw; sw.x = cvtpk(S[2 * ks][0], S[2 * ks][1]); sw.y = cvtpk(S[2 * ks][2], S[2 * ks][3]); sw.z = cvtpk(S[2 * ks + 1][0], S[2 * ks + 1][1]); sw.w = cvtpk(S[2 * ks + 1][2], S[2 * ks + 1][3]);
            const bf16x8 sf = __builtin_bit_cast(bf16x8, sw);
#pragma unroll
            for (int tt = 0; tt < 4; ++tt) {
                const LAS unsigned char* qa = L + OFF_QI + (16 * tt + fr) * IST + (32 * ks + 4 * quad) * 2;
                const v2u lo = *(const LAS v2u*)qa, hi = *(const LAS v2u*)(qa + 32);
                const v4u aw = (v4u){lo.x, lo.y, hi.x, hi.y};
                o[tt] = __builtin_amdgcn_mfma_f32_16x16x32_bf16(__builtin_bit_cast(bf16x8, aw), sf, o[tt], 0, 0, 0);
            }
        }
    }
    if (update) {
#pragma unroll
        for (int kt = 0; kt < 8; ++kt) {
            const f32x4 dc = *(const LAS f32x4*)(L + OFF_DEC + (16 * kt + 4 * quad) * 4);
            f32x4 c = S[kt] * dc;
#pragma unroll
            for (int ts = 0; ts < 2; ++ts) {
                const bf16x8 a = tr8(L + OFF_KH + (32 * ts + 8 * quad + q4) * IST + (16 * kt + 4 * p) * 2, 4 * IST);
                c = __builtin_amdgcn_mfma_f32_16x16x32_bf16(a, vf[ts], c, 0, 0, 0);
            }
            S[kt] = c;
        }
    }
}
__device__ __forceinline__ void pass1(const bf16* HQ, const float* lbraw, float* LST, float* DLG, LAS unsigned char* L, int vcu, int G, int tid, int wave, int lane) {
    const int fr = lane & 15, quad = lane >> 4;
    for (int u = vcu; u < 256; u += G) {
        const int b = u >> 5, h = (u >> 3) & 3, sc = u & 7;
        const int k = tid & 127;
        const float lbk = 1.0f / (1.0f + __expf(lbraw[512 + h * 128 + k] - lbraw[h * 128 + k]));
        f32x4 S[8], o[4];
#pragma unroll
        for (int kt = 0; kt < 8; ++kt) S[kt] = (f32x4){0.f, 0.f, 0.f, 0.f};
        float dlog = 0.f;
#pragma unroll 1
        for (int sub = 0; sub < 4; ++sub) {
            prep<false>(HQ, (size_t)b * SEQ + sc * 256 + sub * 64, h, lbk, L, tid, dlog);
            mainstep<false>(L, wave, lane, S, o, true);
        }
#pragma unroll
        for (int kt = 0; kt < 8; ++kt)
#pragma unroll
            for (int r = 0; r < 4; ++r) LST[((size_t)u * 128 + 16 * kt + 4 * quad + r) * 128 + 16 * wave + fr] = S[kt][r];
        if (tid < 128) DLG[u * 128 + tid] = dlog;
        __syncthreads();
    }
}
__device__ __forceinline__ void pass2(const bf16* HQ, const float* lbraw, const float* onorm, const float* LST, const float* DLG, bf16* YA, LAS unsigned char* L, int vcu, int G, int tid, int wave, int lane) {
    const int fr = lane & 15, quad = lane >> 4;
    LAS float* RS = (LAS float*)(L + OFF_RS);
    for (int u = vcu; u < 256; u += G) {
        const int b = u >> 5, h = (u >> 3) & 3, sc = u & 7;
        const int k = tid & 127;
        const float lbk = 1.0f / (1.0f + __expf(lbraw[512 + h * 128 + k] - lbraw[h * 128 + k]));
        const float gain = onorm[h * 128 + 16 * wave + fr];
        f32x4 S[8], o[4];
#pragma unroll
        for (int kt = 0; kt < 8; ++kt) S[kt] = (f32x4){0.f, 0.f, 0.f, 0.f};
#pragma unroll 1
        for (int j = 0; j < sc; ++j) {
            const int uj = (u & ~7) + j;
#pragma unroll
            for (int kt = 0; kt < 8; ++kt) {
                const f32x4 dl = *(const f32x4*)(DLG + uj * 128 + 16 * kt + 4 * quad);
#pragma unroll
                for (int r = 0; r < 4; ++r) S[kt][r] = __expf(dl[r]) * S[kt][r] + LST[((size_t)uj * 128 + 16 * kt + 4 * quad + r) * 128 + 16 * wave + fr];
            }
        }
        float dlog = 0.f;
#pragma unroll 1
        for (int sub = 0; sub < 4; ++sub) {
            const size_t row0 = (size_t)b * SEQ + sc * 256 + sub * 64;
            prep<true>(HQ, row0, h, lbk, L, tid, dlog);
            scores(L, wave, lane);
            __syncthreads();
            mainstep<true>(L, wave, lane, S, o, sub < 3);
#pragma unroll
            for (int tt = 0; tt < 4; ++tt)
#pragma unroll
                for (int r = 0; r < 4; ++r) {
                    float sq = o[tt][r] * o[tt][r];
                    sq += __shfl_xor(sq, 1); sq += __shfl_xor(sq, 2); sq += __shfl_xor(sq, 4); sq += __shfl_xor(sq, 8);
                    if (fr == 0) RS[(16 * tt + 4 * quad + r) * 8 + wave] = sq;
                }
            __syncthreads();
#pragma unroll
            for (int tt = 0; tt < 4; ++tt)
#pragma unroll
                for (int r = 0; r < 4; ++r) {
                    const int t = 16 * tt + 4 * quad + r;
                    const f32x4 r0 = *(const LAS f32x4*)(RS + t * 8), r1 = *(const LAS f32x4*)(RS + t * 8 + 4);
                    const float tot = ((r0[0] + r0[1]) + (r0[2] + r0[3])) + ((r1[0] + r1[1]) + (r1[2] + r1[3]));
                    const float rs = rsqrtf(tot * (1.0f / 128.0f) + EPS);
                    const size_t row = row0 + t;
                    const float og = bf2f(HQ[row * 2048 + 1536 + h * 128 + 16 * wave + fr]);
                    const float y = o[tt][r] * rs * gain * (og / (1.0f + __expf(-og)));
                    YA[row * 512 + h * 128 + 16 * wave + fr] = (bf16)f2bf(y);
                }
        }
        __syncthreads();
    }
}
}

struct Args { const float* in[15]; float* out; unsigned char* ws; int ph_lo, ph_hi, li, pad; };
__global__ void __launch_bounds__(NWAVES * 64, 2) mk_fwd(Args args) {
    __shared__ __attribute__((aligned(16))) unsigned char lds_raw[LDS_BYTES];
    LAS unsigned char* lds = (LAS unsigned char*)lds_raw;
    volatile LAS unsigned* MISC = (volatile LAS unsigned*)(lds + MISC_OFF);
    const int tid = threadIdx.x, lane = tid & 63, wave = __builtin_amdgcn_readfirstlane(tid >> 6);
    const int G = gridDim.x; const int bx = blockIdx.x; const int vcu = (G % 8 == 0) ? (bx % 8) * (G / 8) + bx / 8 : bx;
    const int gw = vcu * NWAVES + wave, NGW = G * NWAVES;
    unsigned char* ws = args.ws;
    gu32* ctl = (gu32*)(ws + WS_CTL);
    const float* x = args.in[0]; const float* ffn1_norm = args.in[1]; const float* ffn1_wgu = args.in[2]; const float* ffn1_wd = args.in[3]; const float* mix_norm = args.in[4];
    const float* w_in = args.in[5]; const float* hg_lb = args.in[6]; const float* hg_onorm = args.in[7]; const float* w_bhg = args.in[8]; const float* w_batt = args.in[9];
    const float* w_out = args.in[10]; const float* ffn2_norm = args.in[11]; const float* ffn2_wgu = args.in[12]; const float* ffn2_wd = args.in[13]; const float* final_norm = args.in[14];
    float* out = args.out;
    float* SS = (float*)(ws + WS_SS);
    bf16* WGU1 = (bf16*)(ws + WS_WGU1); bf16* WD1 = (bf16*)(ws + WS_WD1); bf16* WGU2 = (bf16*)(ws + WS_WGU2); bf16* WD2 = (bf16*)(ws + WS_WD2);
    bf16* WIN = (bf16*)(ws + WS_WIN); bf16* WA = (bf16*)(ws + WS_WA); bf16* WB = (bf16*)(ws + WS_WB); bf16* WO = (bf16*)(ws + WS_WO);
    bf16* HB = (bf16*)(ws + WS_HB); bf16* HID = (bf16*)(ws + WS_HID); bf16* AQKV = (bf16*)(ws + WS_AQKV); bf16* YB = (bf16*)(ws + WS_YB);
    bf16* HQ = (bf16*)(ws + WS_HQ); bf16* GATES = (bf16*)(ws + WS_GATES); bf16* YA = (bf16*)(ws + WS_YA); bf16* TMP = (bf16*)(ws + WS_TMP); bf16* MERGED = (bf16*)(ws + WS_MERGED);

    for (int u = tid; u < (LDS_BYTES - LDSCTL_OFF) / 4; u += NWAVES * 64) ((LAS unsigned*)(lds + LDSCTL_OFF))[u] = 0u;
    __syncthreads();
    XcdBarrier bar = xcd_barrier_post((unsigned*)(ctl + CW_BAR) + args.li * XCD_BAR_WORDS, MISC + 8);
    const int lo = args.ph_lo, hi = args.ph_hi;
#define IN(k) (lo <= (k) && (k) < hi)
#define SEAM(k) do { if (IN(k) && IN((k) + 1)) xcd_barrier(bar); } while (0)

    constexpr int I_GU = (D / 64) * (NGU / 32), I_DN = (FF / 64) * (D / 32), I_IN = (D / 64) * (NIN / 32), I_BR = (512 / 64) * (D / 32), I_WO = (D / 64) * (D / 32);
    if (IN(0)) {
        LAS float* scr = (LAS float*)(lds + RING_OFF + wave * 16384);
        for (int it = gw; it < I_GU + I_DN; it += NGW) {
            if (it < I_GU) p0_transpose_item(ffn1_wgu, ffn1_norm, D, NGU, WGU1, 1, scr, it, lane);
            else p0_transpose_item(ffn1_wd, nullptr, FF, D, WD1, 0, scr, it - I_GU, lane);
        }
        for (int m = gw; m < M; m += NGW) {
            const GAS f32x4* xr = (const GAS f32x4*)(x + (size_t)m * D) + lane;
            f32x4 v[4]; float s = 0.f;
#pragma unroll
            for (int j = 0; j < 4; ++j) { v[j] = xr[64 * j]; s += (v[j].x * v[j].x + v[j].y * v[j].y) + (v[j].z * v[j].z + v[j].w * v[j].w); }
            s = wave_sum(s);
            if (lane == 0) SS[m] = s;
            GAS unsigned long long* o8 = (GAS unsigned long long*)(HB + (size_t)m * D) + lane;
#pragma unroll
            for (int j = 0; j < 4; ++j) o8[64 * j] = (unsigned long long)pk2(v[j].x, v[j].y) | ((unsigned long long)pk2(v[j].z, v[j].w) << 32);
        }
        for (int i = vcu * (NWAVES * 64) + tid; i < 3 * M; i += G * NWAVES * 64) SS[M + i] = 0.f;
    }
    SEAM(0);
    if (IN(1)) {
        pg8::Gemm g{HB, WGU1, HB, WGU1, D}; pg8::StaticOrder S; S.init(M, NGU, G, bx);
        pg8::EpiSwiGLU E{HID, SS, FF};
        pg8::gemm_phase<pg8::EpiSwiGLU, pg8::StaticOrder, true, true>(lds + RING_OFF, g, S, E);
        const int nfull = ((M / 256) * (NGU / 256)) % G, nidle = nfull ? G - nfull : G, idx = nfull ? bx - nfull : bx;
        if (idx >= 0) {
            LAS float* scr = (LAS float*)(lds + RING_OFF + wave * 16384);
            for (int it = idx * NWAVES + wave; it < I_IN + 2 * I_BR + I_WO; it += nidle * NWAVES) {
                int r = it;
                if (r < I_IN) { p0_transpose_item(w_in, mix_norm, D, NIN, WIN, 2, scr, r, lane); continue; } r -= I_IN;
                if (r < I_BR) { p0_transpose_item(w_bhg, nullptr, 512, D, WA, 0, scr, r, lane); continue; } r -= I_BR;
                if (r < I_BR) { p0_transpose_item(w_batt, nullptr, 512, D, WB, 0, scr, r, lane); continue; } r -= I_BR;
                p0_transpose_item(w_out, nullptr, D, D, WO, 0, scr, r, lane);
            }
        }
    }
    SEAM(1);
    if (IN(2)) {
        pg8::Gemm g{HID, WD1, HID, WD1, FF}; pg8::StaticOrder S; S.init(M, D, G, bx);
        pg8::EpiResid E{x, out, HB, SS + M, 0.5f};
        pg8::gemm_phase<pg8::EpiResid, pg8::StaticOrder, true, true>(lds + RING_OFF, g, S, E);
    }
    SEAM(2);
    if (IN(3)) {
        pg8::Gemm g{HB, WIN + (size_t)4096 * D, HB, WIN + (size_t)4096 * D, D}; pg8::StaticOrder S; S.init(M, NATT, G, bx);
        pg8::EpiProj E{AQKV, NATT, AQKV, NATT, 1 << 30, SS + M};
        pg8::gemm_phase<pg8::EpiProj, pg8::StaticOrder, true, true>(lds + RING_OFF, g, S, E);
        const int nfull = ((M / 256) * (NATT / 256)) % G, nidle = nfull ? G - nfull : G, idx = nfull ? bx - nfull : bx;
        if (idx >= 0) {
            LAS float* scr = (LAS float*)(lds + RING_OFF + wave * 16384);
            for (int it = idx * NWAVES + wave; it < I_GU + I_DN; it += nidle * NWAVES) {
                if (it < I_GU) p0_transpose_item(ffn2_wgu, ffn2_norm, D, NGU, WGU2, 1, scr, it, lane);
                else p0_transpose_item(ffn2_wd, nullptr, FF, D, WD2, 0, scr, it - I_GU, lane);
            }
        }
    }
    SEAM(3);
    if (IN(4)) {
#if ATTN_NAIVE
        attn_naive(AQKV, YB, (LAS float*)(lds + RING_OFF) + wave * 64, gw, NGW, lane);
#else
        attn_phase(AQKV, YB, (bf16*)(ws + WS_O2S), (float*)(ws + WS_LSE), lds + RING_OFF, vcu, G, wave, lane);
#endif
    }
    SEAM(4);
    if (IN(5)) {
        pg8::Gemm g{HB, WIN, HB, WIN, D}; pg8::StaticOrder S; S.init(M, NHG + NGATE, G, bx);
        pg8::EpiProj E{HQ, NHG, GATES, NGATE, NHG / 256, SS + M};
        pg8::gemm_phase<pg8::EpiProj, pg8::StaticOrder, true, true>(lds + RING_OFF, g, S, E);
    }
    SEAM(5);
#if HGRN_NAIVE
    if (IN(6)) { hgrn_naive(HQ, hg_lb, hg_onorm, YA, lds + RING_OFF, tid); }
    SEAM(6);
    SEAM(7);
#else
    if (IN(6)) { hg::pass1(HQ, hg_lb, (float*)(ws + WS_LST), (float*)(ws + WS_DLG), lds + RING_OFF, vcu, G, tid, wave, lane); }
    SEAM(6);
    if (IN(7)) { hg::pass2(HQ, hg_lb, hg_onorm, (const float*)(ws + WS_LST), (const float*)(ws + WS_DLG), YA, lds + RING_OFF, vcu, G, tid, wave, lane); }
    SEAM(7);
#endif
    if (IN(8)) {
        pg8::Gemm g{YA, WA, YB, WB, 512}; pg8::MergeOrder S; S.init(M, D, G, bx);
        pg8::EpiMerge E{GATES, TMP, MERGED};
        pg8::gemm_phase<pg8::EpiMerge, pg8::MergeOrder, true, true>(lds + RING_OFF, g, S, E);
    }
    SEAM(8);
    if (IN(9)) {
        pg8::Gemm g{MERGED, WO, MERGED, WO, D}; pg8::StaticOrder S; S.init(M, D, G, bx);
        pg8::EpiResid E{out, out, HB, SS + 2 * M, 1.0f};
        pg8::gemm_phase<pg8::EpiResid, pg8::StaticOrder, true, true>(lds + RING_OFF, g, S, E);
    }
    SEAM(9);
    if (IN(10)) {
        pg8::Gemm g{HB, WGU2, HB, WGU2, D}; pg8::StaticOrder S; S.init(M, NGU, G, bx);
        pg8::EpiSwiGLU E{HID, SS + 2 * M, FF};
        pg8::gemm_phase<pg8::EpiSwiGLU, pg8::StaticOrder, true, true>(lds + RING_OFF, g, S, E);
    }
    SEAM(10);
    if (IN(11)) {
        pg8::Gemm g{HID, WD2, HID, WD2, FF}; pg8::StaticOrder S; S.init(M, D, G, bx);
        pg8::EpiResid E{out, out, HB, SS + 3 * M, 0.5f};
        pg8::gemm_phase<pg8::EpiResid, pg8::StaticOrder, true, true>(lds + RING_OFF, g, S, E);
    }
    SEAM(11);
    if (IN(12)) {
        for (int m = gw; m < M; m += NGW) {
            GAS f32x4* r = (GAS f32x4*)(out + (size_t)m * D) + lane; const GAS f32x4* gn = (const GAS f32x4*)final_norm + lane;
            const float rs = rsqrtf(SS[3 * M + m] * (1.0f / D) + EPS);
#pragma unroll
            for (int j = 0; j < 4; ++j) { f32x4 v = r[64 * j]; v = v * rs * gn[64 * j]; r[64 * j] = v; }
        }
    }
#undef IN
#undef SEAM
}

extern "C" void kernel_launch(void* const* d_in, const int* in_sizes, int n_in, void* d_out, int out_size, void* d_ws, size_t ws_size, hipStream_t stream) {
    static int grid = 0;
    if (grid == 0) {
        if (n_in != 15 || out_size != M * D || ws_size < WS_END) { fprintf(stderr, "kernel_launch: unexpected shapes (n_in %d out %d ws %zu)\n", n_in, out_size, ws_size); grid = -1; return; }
        int dev = 0, cus = 0;
        if (hipGetDevice(&dev) != hipSuccess || hipDeviceGetAttribute(&cus, hipDeviceAttributeMultiprocessorCount, dev) != hipSuccess) { grid = -1; return; }
        grid = cus;
    }
    if (grid < 0) return;
    if (hipMemsetAsync((char*)d_ws + WS_CTL, 0, CTL_ZERO_BYTES, stream) != hipSuccess) return;
    Args a{};
    for (int i = 0; i < 15; ++i) a.in[i] = (const float*)d_in[i];
    a.out = (float*)d_out; a.ws = (unsigned char*)d_ws;
#if PROBE_REPEAT >= 0
    a.ph_lo = 0; a.ph_hi = PROBE_REPEAT + 1; a.li = 0; hipLaunchKernelGGL(mk_fwd, dim3(grid), dim3(NWAVES * 64), 0, stream, a);
    a.ph_lo = PROBE_REPEAT; a.ph_hi = N_PHASES; a.li = 1; hipLaunchKernelGGL(mk_fwd, dim3(grid), dim3(NWAVES * 64), 0, stream, a);
#else
    for (int li = 0; li < N_LAUNCHES; ++li) {
        a.ph_lo = (N_LAUNCHES == 1) ? 0 : li; a.ph_hi = (N_LAUNCHES == 1) ? N_PHASES : li + 1; a.li = li;
        hipLaunchKernelGGL(mk_fwd, dim3(grid), dim3(NWAVES * 64), 0, stream, a);
    }
#endif
}
```

```cpp
#include <hip/hip_runtime.h>
#include <cstdio>
#include <cstdint>
namespace pg8 {
#define PG8_LAS __attribute__((address_space(3)))
typedef unsigned short bf16_t;
typedef short bf16x8 __attribute__((ext_vector_type(8)));
typedef float f32x4 __attribute__((ext_vector_type(4)));
typedef unsigned u32x4 __attribute__((ext_vector_type(4)));
constexpr int BM = 256, BK = 64, HALF = 128, HTB = HALF * BK * 2  , STAGE_BYTES = 8 * HTB, NXCD = 8, WGM = 8;

__host__ __device__ __forceinline__ int lds_byte(int r, int c) { const int st = (r >> 4) * 2 + (c >> 5), rr = r & 15, cc = c & 31, ob = rr * 64 + cc * 2; return st * 1024 + (ob ^ (((ob >> 9) & 1) << 5)); }
__host__ __device__ __forceinline__ void stage_rc(int b, int& R, int& C) { const int st = b / 1024, sb = b % 1024, swz = sb ^ (((sb >> 9) & 1) << 5); R = (st >> 1) * 16 + swz / 64; C = (st & 1) * 32 + (swz % 64) / 2; }
__host__ __device__ __forceinline__ int perm32(int rho) { const int n = rho >> 4, i = rho & 15; return 8 * (i >> 2) + 4 * n + (i & 3); }

struct Unit { int pm, pn, z; };
struct Gemm { const bf16_t* A; const bf16_t* Bt; const bf16_t* A1; const bf16_t* Bt1; int K; };

struct StaticOrder {
    int nM, nN, nwg, G, c;
    __host__ __device__ void init(int M, int N, int G_, int c_) { nM = M / BM; nN = N / BM; nwg = nM * nN; G = G_; c = c_; }
    __host__ __device__ bool next(int i, Unit& u) const {
        const long L = (long)i * G + c; if (L >= nwg) return false;
        int wgid = (int)L; { const int q = nwg / NXCD, r = nwg % NXCD, xcd = wgid % NXCD, off = wgid / NXCD; wgid = (xcd < r ? xcd * (q + 1) : r * (q + 1) + (xcd - r) * q) + off; }
        const int nig = WGM * nN, gid = wgid / nig, fm = gid * WGM, gsz = (nM - fm) < WGM ? (nM - fm) : WGM;
        u.pm = fm + ((wgid % nig) % gsz); u.pn = (wgid % nig) / gsz; u.z = 0; return true;
    }
    __device__ __forceinline__ void a_ready(const Unit&) const {}
    __device__ __forceinline__ void done(const Unit&) const {}
};


__device__ __forceinline__ unsigned cvt_pk_bf16(float lo, float hi) { unsigned r; asm volatile("v_cvt_pk_bf16_f32 %0, %1, %2" : "=v"(r) : "v"(lo), "v"(hi)); return r; }
typedef float f32x2 __attribute__((ext_vector_type(2)));
__device__ __forceinline__ float fast_sigmoid(float x) { return __builtin_amdgcn_rcpf(1.0f + __builtin_amdgcn_exp2f(-1.4426950408889634f * x)); }
__device__ __forceinline__ float bf_lo(unsigned w) { return __uint_as_float(w << 16); }
__device__ __forceinline__ float bf_hi(unsigned w) { return __uint_as_float(w & 0xffff0000u); }
__device__ __forceinline__ float row_rstd(const float* ss, int row) { return rsqrtf(ss[row] * (1.0f / 1024.0f) + 1e-6f); }
__device__ __forceinline__ u32x4 pack8(const float (&h)[8]) { u32x4 w; w.x = cvt_pk_bf16(h[0], h[1]); w.y = cvt_pk_bf16(h[2], h[3]); w.z = cvt_pk_bf16(h[4], h[5]); w.w = cvt_pk_bf16(h[6], h[7]); return w; }

struct EpiSwiGLU {
    static constexpr bool PERM = true, AFTER_DRAIN = false;
    bf16_t* O; const float* ss; int ldo;
    __device__ __forceinline__ void operator()(const f32x4 (&acc)[2][2][4][2], const Unit& u, int wr, int wc, int fr, int fq) const {
        const int row0 = u.pm * BM + wr * 64 + fr, col0 = u.pn * 128 + wc * 32 + 8 * fq;
#pragma unroll
        for (int ai = 0; ai < 2; ++ai)
#pragma unroll
            for (int m = 0; m < 4; ++m) {
                const int row = row0 + ai * HALF + m * 16; const float rs = row_rstd(ss, row);
                float h[8];
#pragma unroll
                for (int n = 0; n < 2; ++n)
#pragma unroll
                    for (int i = 0; i < 4; ++i) { const float g = acc[ai][0][m][n][i] * rs, up = acc[ai][1][m][n][i] * rs; h[4 * n + i] = g * fast_sigmoid(g) * up; }
                *(u32x4*)(O + (size_t)row * ldo + col0) = pack8(h);
            }
    }
};
template <bool BASE_BF16, bool OUT_F32> struct EpiResid {
    static constexpr bool PERM = true, AFTER_DRAIN = false;
    const float* basef; const bf16_t* baseh; float* outf; bf16_t* hb; float* ss_out; float scale;
    __device__ __forceinline__ void operator()(const f32x4 (&acc)[2][2][4][2], const Unit& u, int wr, int wc, int fr, int fq) const {
        const int row0 = u.pm * BM + wr * 64 + fr;
#pragma unroll
        for (int ai = 0; ai < 2; ++ai)
#pragma unroll
            for (int m = 0; m < 4; ++m) {
                const int row = row0 + ai * HALF + m * 16; float ssq = 0.f;
#pragma unroll
                for (int bj = 0; bj < 2; ++bj) {
                    const size_t off = (size_t)row * 1024 + u.pn * BM + bj * HALF + wc * 32 + 8 * fq;
                    float h[8];
                    if (BASE_BF16) { const u32x4 bw = *(const u32x4*)(baseh + off);
                        h[0] = bf_lo(bw.x); h[1] = bf_hi(bw.x); h[2] = bf_lo(bw.y); h[3] = bf_hi(bw.y); h[4] = bf_lo(bw.z); h[5] = bf_hi(bw.z); h[6] = bf_lo(bw.w); h[7] = bf_hi(bw.w);
                    } else { const f32x4 b0 = *(const f32x4*)(basef + off), b1 = *(const f32x4*)(basef + off + 4);
                        h[0] = b0[0]; h[1] = b0[1]; h[2] = b0[2]; h[3] = b0[3]; h[4] = b1[0]; h[5] = b1[1]; h[6] = b1[2]; h[7] = b1[3]; }
#pragma unroll
                    for (int i = 0; i < 4; ++i) { h[i] += acc[ai][bj][m][0][i] * scale; h[4 + i] += acc[ai][bj][m][1][i] * scale; }
                    if (OUT_F32) { *(f32x4*)(outf + off) = (f32x4){h[0], h[1], h[2], h[3]}; *(f32x4*)(outf + off + 4) = (f32x4){h[4], h[5], h[6], h[7]}; }
                    else *(u32x4*)(hb + off) = pack8(h);
#pragma unroll
                    for (int i = 0; i < 8; ++i) ssq += h[i] * h[i];
                }
                ssq += __shfl_xor(ssq, 16); ssq += __shfl_xor(ssq, 32);
                if (fq == 0) atomicAdd(ss_out + row, ssq);
            }
    }
};
struct EpiProj {
    static constexpr bool PERM = true, AFTER_DRAIN = false;
    bf16_t* o1; int ld1; bf16_t* o2; int ld2; int split_pn; const float* ss;
    __device__ __forceinline__ void operator()(const f32x4 (&acc)[2][2][4][2], const Unit& u, int wr, int wc, int fr, int fq) const {
        const int row0 = u.pm * BM + wr * 64 + fr; const bool second = u.pn >= split_pn;
        bf16_t* dst = second ? o2 : o1; const int ld = second ? ld2 : ld1; const int colt = (second ? u.pn - split_pn : u.pn) * BM + wc * 32 + 8 * fq;
#pragma unroll
        for (int ai = 0; ai < 2; ++ai)
#pragma unroll
            for (int m = 0; m < 4; ++m) {
                const int row = row0 + ai * HALF + m * 16; const float rs = row_rstd(ss, row);
#pragma unroll
                for (int bj = 0; bj < 2; ++bj) {
                    float h[8];
#pragma unroll
                    for (int n = 0; n < 2; ++n)
#pragma unroll
                        for (int i = 0; i < 4; ++i) { const float v = acc[ai][bj][m][n][i] * rs; h[4 * n + i] = second ? fast_sigmoid(v) : v; }
                    *(u32x4*)(dst + (size_t)row * ld + colt + bj * HALF) = pack8(h);
                }
            }
    }
};
struct EpiMerge {
    static constexpr bool PERM = true, AFTER_DRAIN = false;
    const bf16_t* gates; bf16_t* tmp; bf16_t* merged;
    __device__ __forceinline__ void operator()(const f32x4 (&acc)[2][2][4][2], const Unit& u, int wr, int wc, int fr, int fq) const {
        const int row0 = u.pm * BM + wr * 64 + fr;
#pragma unroll
        for (int ai = 0; ai < 2; ++ai)
#pragma unroll
            for (int m = 0; m < 4; ++m) {
                const int row = row0 + ai * HALF + m * 16;
#pragma unroll
                for (int bj = 0; bj < 2; ++bj) {
                    const int col = u.pn * BM + bj * HALF + wc * 32 + 8 * fq;
                    const u32x4 gw = *(const u32x4*)(gates + (size_t)row * 2048 + u.z * 1024 + col);
                    const float gt[8] = {bf_lo(gw.x), bf_hi(gw.x), bf_lo(gw.y), bf_hi(gw.y), bf_lo(gw.z), bf_hi(gw.z), bf_lo(gw.w), bf_hi(gw.w)};
                    float h[8];
#pragma unroll
                    for (int n = 0; n < 2; ++n)
#pragma unroll
                        for (int i = 0; i < 4; ++i) h[4 * n + i] = acc[ai][bj][m][n][i] * gt[4 * n + i];
                    if (u.z) {
                        const u32x4 tw = *(const u32x4*)(tmp + (size_t)row * 1024 + col);
                        h[0] += bf_lo(tw.x); h[1] += bf_hi(tw.x); h[2] += bf_lo(tw.y); h[3] += bf_hi(tw.y); h[4] += bf_lo(tw.z); h[5] += bf_hi(tw.z); h[6] += bf_lo(tw.w); h[7] += bf_hi(tw.w);
                        *(u32x4*)(merged + (size_t)row * 1024 + col) = pack8(h);
                    } else *(u32x4*)(tmp + (size_t)row * 1024 + col) = pack8(h);
                }
            }
    }
};
struct MergeOrder : StaticOrder {
    __host__ __device__ bool next(int i, Unit& u) const { if (!StaticOrder::next(i >> 1, u)) return false; u.z = i & 1; return true; }
};

template <class Epi, class Sched, bool ALIGN_EPI = false, bool SP2 = false>
__device__ __forceinline__ void gemm_phase(PG8_LAS unsigned char* lds, const Gemm g, const Sched& S, const Epi& E) {
    const int tid = threadIdx.x, wid = __builtin_amdgcn_readfirstlane(tid >> 6), lane = tid & 63, wr = wid >> 2, wc = wid & 3, fr = lane & 15, fq = lane >> 4;
    const int K = g.K, nt = K / BK;
    unsigned voffA[2], voffB[2];
#pragma unroll
    for (int i = 0; i < 2; ++i) { int R, C; stage_rc(tid * 16 + i * 8192, R, C); const int Rb = Epi::PERM ? ((R & ~31) + perm32(R & 31)) : R;
        voffA[i] = (unsigned)(R * K + C) * 2u; voffB[i] = (unsigned)(Rb * K + C) * 2u; }
    const size_t kstep = (size_t)(BK * 2);
    const size_t hstep = (size_t)HALF * K * 2;
    const size_t tstep = 2 * hstep;
    const unsigned ldsw = (unsigned)wid * 1024u;
    const int aoff = lds_byte(wr * 64 + fr, fq * 8), boff = lds_byte(wc * 32 + fr, fq * 8);
#define PG8_SA(b, h) (((b) * 2 + (h)) * HTB)
#define PG8_SB(b, h) ((4 + (b) * 2 + (h)) * HTB)
#define PG8_STAGE(bufoff, gbase, voff) do { _Pragma("unroll") for (int _i = 0; _i < 2; ++_i) \
        __builtin_amdgcn_global_load_lds((const unsigned*)((const char*)(gbase) + (voff)[_i]), (PG8_LAS unsigned*)(lds + (bufoff) + ldsw + _i * 8192), 16, 0, 0); } while (0)
#define PG8_LDA(dst, b, h) do { _Pragma("unroll") for (int m = 0; m < 4; ++m) _Pragma("unroll") for (int k = 0; k < 2; ++k) dst[m][k] = *(const PG8_LAS bf16x8*)(lds + PG8_SA(b, h) + aoff + m * 2048 + k * 1024); } while (0)
#define PG8_LDB(dst, b, h) do { _Pragma("unroll") for (int n = 0; n < 2; ++n) _Pragma("unroll") for (int k = 0; k < 2; ++k) dst[n][k] = *(const PG8_LAS bf16x8*)(lds + PG8_SB(b, h) + boff + n * 2048 + k * 1024); } while (0)
#define PG8_MMA(ai, bj, At, Bt) do { __builtin_amdgcn_s_setprio(1); _Pragma("unroll") for (int m = 0; m < 4; ++m) _Pragma("unroll") for (int n = 0; n < 2; ++n) _Pragma("unroll") for (int k = 0; k < 2; ++k) \
        acc[ai][bj][m][n] = __builtin_amdgcn_mfma_f32_16x16x32_bf16(Bt[n][k], At[m][k], acc[ai][bj][m][n], 0, 0, 0); __builtin_amdgcn_s_setprio(0); } while (0)
#define PG8_WAIT_V(n) asm volatile("s_waitcnt vmcnt(" #n ")" ::: "memory")
#define PG8_WAIT_L(n) asm volatile("s_waitcnt lgkmcnt(" #n ")" ::: "memory")
#define PG8_BAR __builtin_amdgcn_s_barrier()
#define PG8_SCHED __builtin_amdgcn_sched_barrier(0)
    Unit cur, nxt; int ui = 0;
    if (!S.next(0, cur)) return;
    f32x4 acc[2][2][4][2];
#pragma unroll
    for (int a = 0; a < 2; ++a)
#pragma unroll
        for (int b = 0; b < 2; ++b)
#pragma unroll
            for (int m = 0; m < 4; ++m)
#pragma unroll
                for (int n = 0; n < 2; ++n) acc[a][b][m][n] = (f32x4){0.f, 0.f, 0.f, 0.f};
    bf16x8 At[4][2], B0[2][2], B1[2][2];
    const char* cA = (const char*)(cur.z ? g.A1 : g.A) + (size_t)cur.pm * tstep; const char* cB = (const char*)(cur.z ? g.Bt1 : g.Bt) + (size_t)cur.pn * tstep;
    S.a_ready(cur);
    if constexpr (SP2) {
        PG8_STAGE(PG8_SB(0, 0), cB, voffB); PG8_STAGE(PG8_SB(0, 1), cB + hstep, voffB); PG8_STAGE(PG8_SA(0, 0), cA, voffA); PG8_STAGE(PG8_SA(0, 1), cA + hstep, voffA);
        if (wr == 1) PG8_BAR;
        PG8_WAIT_V(2); PG8_BAR;
        PG8_STAGE(PG8_SB(1, 0), cB + kstep, voffB); PG8_STAGE(PG8_SA(1, 0), cA + kstep, voffA); PG8_STAGE(PG8_SB(1, 1), cB + hstep + kstep, voffB);
        PG8_WAIT_V(6); PG8_BAR;
    } else {
        PG8_STAGE(PG8_SB(0, 0), cB, voffB); PG8_STAGE(PG8_SA(0, 0), cA, voffA); PG8_STAGE(PG8_SB(0, 1), cB + hstep, voffB); PG8_STAGE(PG8_SA(0, 1), cA + hstep, voffA);
        if (wr == 1) PG8_BAR;
        PG8_WAIT_V(4); PG8_BAR;
        PG8_STAGE(PG8_SB(1, 0), cB + kstep, voffB); PG8_STAGE(PG8_SA(1, 0), cA + kstep, voffA); PG8_STAGE(PG8_SB(1, 1), cB + hstep + kstep, voffB);
        PG8_WAIT_V(6); PG8_BAR;
    }
    for (;;) {
        const bool has_next = S.next(ui + 1, nxt);
        const char* nA = has_next ? (const char*)(nxt.z ? g.A1 : g.A) + (size_t)nxt.pm * tstep : cA; const char* nB = has_next ? (const char*)(nxt.z ? g.Bt1 : g.Bt) + (size_t)nxt.pn * tstep : cB;
        for (int t = 0; t < nt; t += 2) {
            const bool last = (t == nt - 2);
            const char* a1 = cA + (size_t)(t + 1) * kstep;
            const char* a2 = last ? nA : cA + (size_t)(t + 2) * kstep; const char* b2 = last ? nB : cB + (size_t)(t + 2) * kstep;
            const char* a3 = a2 + kstep; const char* b3 = b2 + kstep;
            if (last && has_next) S.a_ready(nxt);
            if constexpr (SP2) {
            PG8_LDB(B0, 0, 0); PG8_LDB(B1, 0, 1); PG8_SCHED; PG8_LDA(At, 0, 0); PG8_STAGE(PG8_SA(1, 1), a1 + hstep, voffA);
            PG8_WAIT_V(8); PG8_WAIT_L(0); PG8_BAR; PG8_MMA(0, 0, At, B0); PG8_MMA(0, 1, At, B1); PG8_BAR; PG8_SCHED;
            PG8_LDA(At, 0, 1); PG8_STAGE(PG8_SB(0, 0), b2, voffB); PG8_STAGE(PG8_SB(0, 1), b2 + hstep, voffB); PG8_STAGE(PG8_SA(0, 0), a2, voffA);
            PG8_WAIT_V(8); PG8_WAIT_L(0); PG8_BAR; PG8_MMA(1, 0, At, B0); PG8_MMA(1, 1, At, B1); PG8_BAR; PG8_SCHED;
            PG8_LDB(B0, 1, 0); PG8_LDB(B1, 1, 1); PG8_SCHED; PG8_LDA(At, 1, 0); PG8_STAGE(PG8_SA(0, 1), a2 + hstep, voffA);
            PG8_WAIT_V(8); PG8_WAIT_L(0); PG8_BAR; PG8_MMA(0, 0, At, B0); PG8_MMA(0, 1, At, B1); PG8_BAR; PG8_SCHED;
            PG8_LDA(At, 1, 1); PG8_STAGE(PG8_SB(1, 0), b3, voffB); PG8_STAGE(PG8_SB(1, 1), b3 + hstep, voffB); PG8_STAGE(PG8_SA(1, 0), a3, voffA);
            PG8_WAIT_V(8); PG8_WAIT_L(0); PG8_BAR; PG8_MMA(1, 0, At, B0); PG8_MMA(1, 1, At, B1); PG8_BAR; PG8_SCHED;
            } else {
            PG8_LDB(B0, 0, 0); PG8_SCHED; PG8_LDA(At, 0, 0); PG8_STAGE(PG8_SA(1, 1), a1 + hstep, voffA);
            PG8_WAIT_L(8); PG8_BAR; PG8_WAIT_L(0); PG8_MMA(0, 0, At, B0); PG8_BAR; PG8_SCHED;
            PG8_LDB(B1, 0, 1); PG8_STAGE(PG8_SB(0, 0), b2, voffB);
            PG8_BAR; PG8_WAIT_L(0); PG8_MMA(0, 1, At, B1); PG8_BAR;
            PG8_LDA(At, 0, 1); PG8_STAGE(PG8_SA(0, 0), a2, voffA);
            PG8_BAR; PG8_WAIT_L(0); PG8_MMA(1, 0, At, B0); PG8_BAR; PG8_SCHED;
            PG8_STAGE(PG8_SB(0, 1), b2 + hstep, voffB);
            PG8_WAIT_V(6); PG8_BAR; PG8_MMA(1, 1, At, B1); PG8_BAR;
            PG8_LDB(B0, 1, 0); PG8_SCHED; PG8_LDA(At, 1, 0); PG8_STAGE(PG8_SA(0, 1), a2 + hstep, voffA);
            PG8_WAIT_L(8); PG8_BAR; PG8_WAIT_L(0); PG8_MMA(0, 0, At, B0); PG8_BAR; PG8_SCHED;
            PG8_LDB(B1, 1, 1); PG8_STAGE(PG8_SB(1, 0), b3, voffB);
            PG8_BAR; PG8_WAIT_L(0); PG8_MMA(0, 1, At, B1); PG8_BAR;
            PG8_LDA(At, 1, 1); PG8_STAGE(PG8_SA(1, 0), a3, voffA);
            PG8_BAR; PG8_WAIT_L(0); PG8_MMA(1, 0, At, B0); PG8_BAR; PG8_SCHED;
            PG8_STAGE(PG8_SB(1, 1), b3 + hstep, voffB);
            PG8_WAIT_V(6); PG8_BAR; PG8_MMA(1, 1, At, B1); PG8_BAR;
            }
        }
        if constexpr (ALIGN_EPI) { if (wr == 0) PG8_BAR; }
        if constexpr (!Epi::AFTER_DRAIN) { E(acc, cur, wr, wc, fr, fq); S.done(cur); }
        if (!has_next) break;
#pragma unroll
        for (int a = 0; a < 2; ++a)
#pragma unroll
            for (int b = 0; b < 2; ++b)
#pragma unroll
                for (int m = 0; m < 4; ++m)
#pragma unroll
                    for (int n = 0; n < 2; ++n) acc[a][b][m][n] = (f32x4){0.f, 0.f, 0.f, 0.f};
        cur = nxt; cA = nA; cB = nB; ++ui;
        if constexpr (ALIGN_EPI) { if (wr == 1) PG8_BAR; }
    }
    PG8_WAIT_V(0);
    if constexpr (!ALIGN_EPI) { if (wr == 0) PG8_BAR; }
    PG8_BAR;
    if constexpr (Epi::AFTER_DRAIN) { E.fused(acc, cur, wr, wc, fr, fq, lds, wid, lane); S.done(cur); }
#undef PG8_SA
#undef PG8_SB
#undef PG8_STAGE
#undef PG8_LDA
#undef PG8_LDB
#undef PG8_MMA
#undef PG8_WAIT_V
#undef PG8_WAIT_L
#undef PG8_BAR
#undef PG8_SCHED
}
}

#define GAS __attribute__((address_space(1)))
#define LAS __attribute__((address_space(3)))
typedef unsigned short bf16;
typedef unsigned v4u __attribute__((ext_vector_type(4)));
typedef float f32x4 __attribute__((ext_vector_type(4)));
typedef short bf16x8 __attribute__((ext_vector_type(8)));
typedef GAS unsigned gu32;
typedef GAS unsigned long long gu64;
#define RLX_AGENT __ATOMIC_RELAXED, __HIP_MEMORY_SCOPE_AGENT
#define LDS_WAIT() asm volatile("s_waitcnt lgkmcnt(0)" ::: "memory")
#define VM_WAIT() asm volatile("s_waitcnt vmcnt(0)" ::: "memory")
__device__ __forceinline__ unsigned long long rt() { return __builtin_amdgcn_s_memrealtime(); }
__device__ __forceinline__ unsigned f2bf(float f) { unsigned u = __builtin_bit_cast(unsigned, f); return (u + 0x7fffu + ((u >> 16) & 1u)) >> 16; }
__device__ __forceinline__ unsigned pk2(float lo, float hi) { return f2bf(lo) | (f2bf(hi) << 16); }
#define XB_TMO      128
#define XB_XCNT(j)  (256  + 64 * (j))
#define XB_XSUB(j)  (1280 + 64 * (j))
#define XB_XGEN(j)  (2304 + 64 * (j))
#define XB_TOP      3328
#define XB_TOPGEN   3392
#define XCD_BAR_WORDS 3456
#define XB_SPIN_CAP (1u << 18)

__device__ __forceinline__ unsigned xb_ld(unsigned* p)              { return __hip_atomic_load(p, __ATOMIC_RELAXED, __HIP_MEMORY_SCOPE_AGENT); }
__device__ __forceinline__ unsigned xb_add(unsigned* p, unsigned v) { return __hip_atomic_fetch_add(p, v, __ATOMIC_RELAXED, __HIP_MEMORY_SCOPE_AGENT); }
__device__ __forceinline__ unsigned xb_xcc_id() { return (unsigned)__builtin_amdgcn_s_getreg((3 << 11) | 20) & 0xFu; }
#define XB_SPIN(cond, bar) do { unsigned _sp = 0; while (cond) { __builtin_amdgcn_s_sleep(1); \
    if ((++_sp & 255u) == 0u) { if (xb_ld(&(bar)[XB_TMO])) break; if (_sp > XB_SPIN_CAP) { atomicAdd(&(bar)[XB_TMO], 1u); break; } } } } while (0)

struct XcdBarrier {
    unsigned* bar; unsigned x;
    volatile LAS unsigned* st;
};

__device__ __forceinline__ XcdBarrier xcd_barrier_post(unsigned* bar, volatile LAS unsigned* st) {
    XcdBarrier b; b.bar = bar; b.x = xb_xcc_id(); b.st = st;
    if (threadIdx.x == 0) (void)xb_add(&bar[XB_XCNT(b.x)], 1u);
    return b;
}
__device__ __forceinline__ void xcd_barrier_complete(unsigned* bar, unsigned x, unsigned& nloc, unsigned& nx) {
    const unsigned G = gridDim.x * gridDim.y * gridDim.z;
    unsigned sum, cnt, mine, sp = 0u;
    for (;;) {
        sum = 0u; cnt = 0u; mine = 0u;
#pragma unroll
        for (unsigned j = 0; j < 16; ++j) { const unsigned c = xb_ld(&bar[XB_XCNT(j)]); sum += c; cnt += (c > 0u) ? 1u : 0u; mine = (j == x) ? c : mine; }
        if (sum == G) break;
        __builtin_amdgcn_s_sleep(1);
        if ((++sp & 255u) == 0u) { if (xb_ld(&bar[XB_TMO])) break; if (sp > XB_SPIN_CAP) { atomicAdd(&bar[XB_TMO], 1u); break; } }
    }
    nloc = mine > 0u ? mine : 1u; nx = cnt > 0u ? cnt : 1u;
}

__device__ __forceinline__ void xcd_barrier(const XcdBarrier& b) {
    asm volatile("s_waitcnt vmcnt(0)" ::: "memory");
    __syncthreads();
    if (threadIdx.x == 0) {
        unsigned* bar = b.bar;
        __builtin_amdgcn_s_waitcnt(0);
        unsigned nloc = b.st[0], nx = b.st[1];
        if (nloc == 0u) { xcd_barrier_complete(bar, b.x, nloc, nx); b.st[0] = nloc; b.st[1] = nx; }
        const unsigned old = xb_add(&bar[XB_XSUB(b.x)], 1u);
        const unsigned gen = old / nloc;
        if (old + 1u == (gen + 1u) * nloc) {
            __builtin_amdgcn_fence(__ATOMIC_RELEASE, "agent");
            asm volatile("s_waitcnt vmcnt(0)" ::: "memory");
            const unsigned og = xb_add(&bar[XB_TOP], 1u);
            const unsigned tg = og / nx;
            if (og + 1u == (tg + 1u) * nx) xb_add(&bar[XB_TOPGEN], 1u);
            else XB_SPIN(xb_ld(&bar[XB_TOPGEN]) == tg, bar);
            __builtin_amdgcn_fence(__ATOMIC_ACQUIRE, "agent");
            xb_add(&bar[XB_XGEN(b.x)], 1u);
            asm volatile("s_waitcnt vmcnt(0)" ::: "memory");
        } else {
            XB_SPIN(xb_ld(&bar[XB_XGEN(b.x)]) == gen, bar);
            __builtin_amdgcn_fence(__ATOMIC_ACQUIRE, "agent");
            asm volatile("s_waitcnt vmcnt(0)" ::: "memory");
        }
    }
    __syncthreads();
}

constexpr int NWAVES = 8;
#ifndef PROBE_REPEAT
#define PROBE_REPEAT -1
#endif
#ifndef HGRN_NAIVE
#define HGRN_NAIVE 0
#endif
#ifndef ATTN_NAIVE
#define ATTN_NAIVE 0
#endif
#ifndef MK_N_LAUNCHES
#define MK_N_LAUNCHES 1
#endif
constexpr int N_PHASES = 13;
constexpr int N_LAUNCHES = MK_N_LAUNCHES;

constexpr int M = 16384, SEQ = 2048, D = 1024, FF = 2816, NGU = 2 * FF, NIN = 8704, NATT = 4608, NHG = 2048, NGATE = 2048;
constexpr float EPS = 1e-6f;

constexpr size_t MiB = 1u << 20;
constexpr size_t WS_CTL = 0, CTL_ZERO_BYTES = 1 * MiB;
constexpr size_t WS_SS = 1 * MiB;
constexpr size_t WS_WGU1 = 2 * MiB, WS_WD1 = 13 * MiB, WS_WGU2 = 18 * MiB + 512 * 1024, WS_WD2 = 29 * MiB + 512 * 1024, WS_WIN = 35 * MiB, WS_WA = 52 * MiB, WS_WB = 53 * MiB, WS_WO = 54 * MiB;
constexpr size_t WS_HB = 56 * MiB;
constexpr size_t WS_BIG = 88 * MiB;
constexpr size_t WS_HID = WS_BIG;
constexpr size_t WS_AQKV = WS_BIG, WS_YB = 232 * MiB;
constexpr size_t WS_HQ = WS_BIG, WS_GATES = 152 * MiB, WS_YA = 216 * MiB;
constexpr size_t WS_TMP = WS_BIG, WS_MERGED = 120 * MiB;
constexpr size_t WS_O2S = 2 * MiB, WS_LSE = 248 * MiB;
constexpr size_t WS_LST = 2 * MiB, WS_DLG = 249 * MiB;
constexpr size_t WS_END = 256 * MiB;
static_assert(WS_WGU1 + (size_t)NGU * D * 2 <= WS_WD1 && WS_WD1 + (size_t)D * FF * 2 <= WS_WGU2 && WS_WGU2 + (size_t)NGU * D * 2 <= WS_WD2 && WS_WD2 + (size_t)D * FF * 2 <= WS_WIN && WS_WIN + (size_t)NIN * D * 2 <= WS_WA, "ws map: weights");
static_assert(WS_HB + (size_t)M * D * 2 <= WS_BIG && WS_HID + (size_t)M * FF * 2 <= WS_END && WS_AQKV + (size_t)M * NATT * 2 <= WS_YB && WS_YB + (size_t)M * 512 * 2 <= WS_END, "ws map: acts");
static_assert(WS_HQ + (size_t)M * NHG * 2 <= WS_GATES && WS_GATES + (size_t)M * NGATE * 2 <= WS_YA && WS_YA + (size_t)M * 512 * 2 <= WS_YB && WS_TMP + (size_t)M * D * 2 <= WS_MERGED && WS_MERGED + (size_t)M * D * 2 <= WS_GATES, "ws map: mixer");
constexpr int CW_BAR = 4096;

constexpr int RING_OFF = 0, RING_BYTES = 131072;
constexpr int LDSCTL_OFF = RING_BYTES, MISC_OFF = LDSCTL_OFF + 320;
constexpr int LDS_BYTES = 147456;

__device__ __forceinline__ float bf2f(bf16 x) { return __uint_as_float((unsigned)x << 16); }
__device__ __forceinline__ float wave_sum(float v) {
#pragma unroll
    for (int o = 1; o < 64; o <<= 1) v += __shfl_xor(v, o);
    return v;
}
__device__ __forceinline__ float wave_max(float v) {
#pragma unroll
    for (int o = 1; o < 64; o <<= 1) v = fmaxf(v, __shfl_xor(v, o));
    return v;
}
__device__ __forceinline__ float sigmoidf_(float x) { return 1.0f / (1.0f + __expf(-x)); }

__device__ __forceinline__ void p0_transpose_item(const float* W, const float* gain, int K, int N, bf16* WT, int mapmode, LAS float* scr, int item, int lane) {
    const int nblk = N / 32, kb = item / nblk, nb = item % nblk, k0 = 64 * kb, n0 = 32 * nb;
    int d0;
    if (mapmode == 1) { const int bj = n0 >= FF ? 1 : 0, c = n0 - bj * FF; d0 = (c >> 7) * 256 + bj * 128 + (c & 127); }
    else if (mapmode == 2) { d0 = n0 < 2048 ? n0 : (n0 < 6656 ? 4096 + (n0 - 2048) : 2048 + (n0 - 6656)); }
    else d0 = n0;
#pragma unroll
    for (int i = 0; i < 8; ++i) { const int kk = 8 * i + (lane >> 3), c4 = 4 * (lane & 7); const float g = gain ? gain[k0 + kk] : 1.0f;
        const f32x4 w = *(const GAS f32x4*)(W + (size_t)(k0 + kk) * N + n0 + c4);
        scr[kk * 33 + c4] = w.x * g; scr[kk * 33 + c4 + 1] = w.y * g; scr[kk * 33 + c4 + 2] = w.z * g; scr[kk * 33 + c4 + 3] = w.w * g; }
    LDS_WAIT(); asm volatile("" ::: "memory");
    const int c = lane & 7;
#pragma unroll
    for (int j = 0; j < 4; ++j) { const int n = (lane >> 3) + 8 * j; const LAS float* s = scr + (8 * c) * 33 + n;
        v4u o; o.x = pk2(s[0 * 33], s[1 * 33]); o.y = pk2(s[2 * 33], s[3 * 33]); o.z = pk2(s[4 * 33], s[5 * 33]); o.w = pk2(s[6 * 33], s[7 * 33]);
        *(GAS v4u*)(WT + (size_t)(d0 + n) * K + k0 + 8 * c) = o; }
    LDS_WAIT(); asm volatile("" ::: "memory");
}

__device__ __forceinline__ void hgrn_naive(const bf16* HQ, const float* lbraw, const float* onorm, bf16* YA, LAS unsigned char* lds, int tid) {
    if (blockIdx.x >= 16) return;
    constexpr int TB = 8;
    LAS f32x4* L4 = (LAS f32x4*)lds;
    LAS float* OB = (LAS float*)(lds + 2 * TB * 128 * 16);
    LAS float* WSUM = OB + 2 * TB * 2 * 128;
    const int cw = tid >> 8, kh = (tid >> 7) & 1, v = tid & 127, lane = tid & 63, wv = (tid >> 6) & 1;
    const int chain = blockIdx.x * 2 + cw, b = chain >> 2, h = chain & 3;
    const float a0 = lbraw[h * 128 + v], a1 = lbraw[512 + h * 128 + v];
    const float lb = 1.0f / (1.0f + __expf(a1 - a0));
    const float gain = onorm[h * 128 + v];
    float S[64];
#pragma unroll
    for (int k = 0; k < 64; ++k) S[k] = 0.f;
    for (int t0 = 0; t0 < SEQ; t0 += TB) {
#pragma unroll 1
        for (int tt = kh; tt < TB; tt += 2) {
            const size_t row = (size_t)b * SEQ + t0 + tt;
            const float qv = bf2f(HQ[row * 2048 + h * 128 + v]), fp = bf2f(HQ[row * 2048 + 512 + h * 128 + v]);
            const float f = lb + (1.0f - lb) * sigmoidf_(fp);
            L4[(cw * TB + tt) * 128 + v] = (f32x4){qv, f, 1.0f - f, 0.f};
        }
        __syncthreads();
#pragma unroll 1
        for (int tt = 0; tt < TB; ++tt) {
            const size_t row = (size_t)b * SEQ + t0 + tt;
            const float iv = bf2f(HQ[row * 2048 + 1024 + h * 128 + v]);
            float ot = 0.f;
#pragma unroll
            for (int kg = 0; kg < 8; ++kg) {
#pragma unroll
                for (int k8 = 0; k8 < 8; ++k8) { const int k = kg * 8 + k8; const f32x4 e = L4[(cw * TB + tt) * 128 + kh * 64 + k]; S[k] = e[1] * S[k] + e[2] * iv; ot += e[0] * S[k]; }
                __builtin_amdgcn_sched_barrier(0);
            }
            OB[((cw * TB + tt) * 2 + kh) * 128 + v] = ot;
        }
        __syncthreads();
        float o4[4];
#pragma unroll
        for (int i = 0; i < 4; ++i) {
            const int tt = 2 * i + kh;
            o4[i] = OB[((cw * TB + tt) * 2 + 0) * 128 + v] + OB[((cw * TB + tt) * 2 + 1) * 128 + v];
            const float sq = wave_sum(o4[i] * o4[i]);
            if (lane == 0) WSUM[(cw * TB + tt) * 2 + wv] = sq;
        }
        __syncthreads();
#pragma unroll
        for (int i = 0; i < 4; ++i) {
            const int tt = 2 * i + kh;
            const size_t row = (size_t)b * SEQ + t0 + tt;
            const float tot = WSUM[(cw * TB + tt) * 2] + WSUM[(cw * TB + tt) * 2 + 1];
            const float rs = rsqrtf(tot * (1.0f / 128.0f) + EPS);
            const float og = bf2f(HQ[row * 2048 + 1536 + h * 128 + v]);
            const float y = o4[i] * rs * gain * (og * sigmoidf_(og));
            YA[row * 512 + h * 128 + v] = (bf16)f2bf(y);
        }
        __syncthreads();
    }
}

__device__ __forceinline__ void attn_naive(const bf16* AQKV, bf16* YB, LAS float* wq, int gw, int NGW, int lane) {
    for (int unit = gw; unit < M * 8; unit += NGW) {
        const int row = unit >> 3, hs = unit & 7, b = row >> 11, s = row & (SEQ - 1);
        float m_run = -1e30f, l_run = 0.f, acc = 0.f;
#pragma unroll 1
        for (int g = 0; g < 3; ++g) {
            const int d = g == 0 ? 1 : (g == 1 ? 4 : 16);
            const float slope = exp2f(-8.0f * (float)(g * 8 + hs + 1) / 24.0f);
            const int qcol = g * 1536 + hs * 64, kcol = qcol + 512, vcol = qcol + 1024;
            wq[lane] = bf2f(AQKV[(size_t)row * NATT + qcol + lane]) * 0.125f;
            const int lq = s / d, nk = (lq < 128 ? lq : 128) + 1;
#pragma unroll 1
            for (int c0 = 0; c0 < nk; c0 += 64) {
                const int j = c0 + lane; const bool valid = j < nk;
                float sc = -1e30f;
                if (valid) {
                    const bf16* kr = AQKV + (size_t)(b * SEQ + s - j * d) * NATT + kcol;
                    float dot = 0.f;
#pragma unroll
                    for (int e8 = 0; e8 < 8; ++e8) {
                        const v4u w = *(const v4u*)(kr + e8 * 8);
                        dot += wq[e8 * 8 + 0] * __uint_as_float(w.x << 16) + wq[e8 * 8 + 1] * __uint_as_float(w.x & 0xffff0000u)
                             + wq[e8 * 8 + 2] * __uint_as_float(w.y << 16) + wq[e8 * 8 + 3] * __uint_as_float(w.y & 0xffff0000u)
                             + wq[e8 * 8 + 4] * __uint_as_float(w.z << 16) + wq[e8 * 8 + 5] * __uint_as_float(w.z & 0xffff0000u)
                             + wq[e8 * 8 + 6] * __uint_as_float(w.w << 16) + wq[e8 * 8 + 7] * __uint_as_float(w.w & 0xffff0000u);
                    }
                    sc = dot - slope * (float)(d * j);
                }
                const float m_new = fmaxf(m_run, wave_max(sc));
                const float p = valid ? __expf(sc - m_new) : 0.f;
                const float corr = __expf(m_run - m_new);
                l_run = l_run * corr + wave_sum(p); acc *= corr; m_run = m_new;
                const int cnt = (nk - c0) < 64 ? (nk - c0) : 64;
#pragma unroll 1
                for (int jj = 0; jj < cnt; ++jj) {
                    const float pj = __uint_as_float(__builtin_amdgcn_readlane(__float_as_uint(p), jj));
                    acc += pj * bf2f(AQKV[(size_t)(b * SEQ + s - (c0 + jj) * d) * NATT + vcol + lane]);
                }
            }
        }
        YB[(size_t)row * 512 + hs * 64 + lane] = (bf16)f2bf(acc / l_run);
    }
}

typedef float f32x16 __attribute__((ext_vector_type(16)));
typedef short s16x4 __attribute__((ext_vector_type(4)));
typedef short v4i16_t __attribute__((ext_vector_type(4)));
typedef unsigned v2u __attribute__((ext_vector_type(2)));
__device__ __forceinline__ s16x4 lds_tr(const LAS unsigned char* p) { return __builtin_bit_cast(s16x4, __builtin_amdgcn_ds_read_tr16_b64_v4i16((LAS v4i16_t*)p)); }
__device__ __forceinline__ unsigned cvtpk(float lo, float hi) { unsigned r; asm volatile("v_cvt_pk_bf16_f32 %0, %1, %2" : "=v"(r) : "v"(lo), "v"(hi)); return r; }

__device__ __forceinline__ void attn_tile(const bf16* AQKV, int b, int hs, int g, int d, int res, int l0, LAS unsigned char* vst, int lane,
                                          f32x16& o0, f32x16& o1, float& m_run, float& l_run) {
    const int r32 = lane & 31, hi = lane >> 5;
    const int qcol = g * 1536 + hs * 64, kcol = qcol + 512, vcol = qcol + 1024;
    const float slope = exp2f(-8.0f * (float)(g * 8 + hs + 1) / 24.0f);
    const float c1 = 0.125f * 1.4426950408889634f, c2 = slope * (float)d * 1.4426950408889634f;
    const size_t qrow = (size_t)b * SEQ + (size_t)(l0 + r32) * d + res;
    bf16x8 qf[4];
#pragma unroll
    for (int kk = 0; kk < 4; ++kk) qf[kk] = *(const bf16x8*)(AQKV + qrow * NATT + qcol + kk * 16 + hi * 8);
#pragma unroll
    for (int r = 0; r < 16; ++r) { o0[r] = 0.f; o1[r] = 0.f; }
    m_run = -1e30f; l_run = 0.f;
    const int lq = l0 + r32;
    const int kt0 = (l0 >= 128) ? 0 : 4 - (l0 >> 5);
    bf16x8 kn[4]; v4u vn[4];
    {
        const int k0 = l0 - 128 + 32 * kt0;
        const size_t krow = (size_t)b * SEQ + (size_t)(k0 + r32) * d + res;
#pragma unroll
        for (int kk = 0; kk < 4; ++kk) kn[kk] = *(const bf16x8*)(AQKV + krow * NATT + kcol + kk * 16 + hi * 8);
#pragma unroll
        for (int i = 0; i < 4; ++i) { const size_t vrow = (size_t)b * SEQ + (size_t)(k0 + (lane >> 3) + 8 * i) * d + res; vn[i] = *(const v4u*)(AQKV + vrow * NATT + vcol + (lane & 7) * 8); }
    }
#pragma unroll 1
    for (int kt = kt0; kt < 5; ++kt) {
        const int k0 = l0 - 128 + 32 * kt;
        bf16x8 kf[4];
#pragma unroll
        for (int kk = 0; kk < 4; ++kk) kf[kk] = kn[kk];
#pragma unroll
        for (int i = 0; i < 4; ++i) { const int key = (lane >> 3) + 8 * i, cc = lane & 7; *(LAS v4u*)(vst + (cc >> 2) * 2048 + key * 64 + (cc & 3) * 16) = vn[i]; }
        if (kt < 4) {
            const int k1 = k0 + 32;
            const size_t krow = (size_t)b * SEQ + (size_t)(k1 + r32) * d + res;
#pragma unroll
            for (int kk = 0; kk < 4; ++kk) kn[kk] = *(const bf16x8*)(AQKV + krow * NATT + kcol + kk * 16 + hi * 8);
#pragma unroll
            for (int i = 0; i < 4; ++i) { const size_t vrow = (size_t)b * SEQ + (size_t)(k1 + (lane >> 3) + 8 * i) * d + res; vn[i] = *(const v4u*)(AQKV + vrow * NATT + vcol + (lane & 7) * 8); }
        }
        f32x16 s;
#pragma unroll
        for (int r = 0; r < 16; ++r) s[r] = 0.f;
#pragma unroll
        for (int kk = 0; kk < 4; ++kk) s = __builtin_amdgcn_mfma_f32_32x32x16_bf16(kf[kk], qf[kk], s, 0, 0, 0);
        float tmax = -1e30f;
#pragma unroll
        for (int r = 0; r < 16; ++r) {
            const int keyi = (r & 3) + 8 * (r >> 2) + 4 * hi;
            const int delta = lq - (k0 + keyi);
            const float t = s[r] * c1 - c2 * (float)delta;
            s[r] = (delta >= 0 && delta <= 128) ? t : -1e30f;
            tmax = fmaxf(tmax, s[r]);
        }
        tmax = fmaxf(tmax, __shfl_xor(tmax, 32));
        const float m_new = fmaxf(m_run, tmax);
        const float corr = __builtin_amdgcn_exp2f(m_run - m_new);
        float psum = 0.f;
#pragma unroll
        for (int r = 0; r < 16; ++r) { s[r] = __builtin_amdgcn_exp2f(s[r] - m_new); psum += s[r]; }
        psum += __shfl_xor(psum, 32);
        l_run = l_run * corr + psum; m_run = m_new;
#pragma unroll
        for (int r = 0; r < 16; ++r) { o0[r] *= corr; o1[r] *= corr; }
        bf16x8 pf[2];
#pragma unroll
        for (int si = 0; si < 2; ++si) {
            v4u w; w.x = cvtpk(s[8 * si + 0], s[8 * si + 1]); w.y = cvtpk(s[8 * si + 2], s[8 * si + 3]); w.z = cvtpk(s[8 * si + 4], s[8 * si + 5]); w.w = cvtpk(s[8 * si + 6], s[8 * si + 7]);
            pf[si] = __builtin_bit_cast(bf16x8, w);
        }
#pragma unroll
        for (int si = 0; si < 2; ++si) {
            const LAS unsigned char* vb = vst + (16 * si + 4 * hi + ((lane & 15) >> 2)) * 64 + ((lane >> 4) & 1) * 32 + (lane & 3) * 8;
            const s16x4 a0 = lds_tr(vb), a1 = lds_tr(vb + 512), b0 = lds_tr(vb + 2048), b1 = lds_tr(vb + 2048 + 512);
            const bf16x8 vf0 = (bf16x8){a0[0], a0[1], a0[2], a0[3], a1[0], a1[1], a1[2], a1[3]};
            const bf16x8 vf1 = (bf16x8){b0[0], b0[1], b0[2], b0[3], b1[0], b1[1], b1[2], b1[3]};
            o0 = __builtin_amdgcn_mfma_f32_32x32x16_bf16(vf0, pf[si], o0, 0, 0, 0);
            o1 = __builtin_amdgcn_mfma_f32_32x32x16_bf16(vf1, pf[si], o1, 0, 0, 0);
        }
    }
}

__device__ __forceinline__ void attn_phase(const bf16* AQKV, bf16* YB, bf16* O2S, float* LSE, LAS unsigned char* lds, int vcu, int G, int wave, int lane) {
    LAS unsigned char* vst = lds + wave * 4096;
    const int r32 = lane & 31, hi = lane >> 5;
    for (int u = vcu; u < 256; u += G) {
        const int b = u >> 5, hs = (u >> 2) & 7, P0 = (u & 3) * 512;
#pragma unroll 1
        for (int i = 0; i < 4; ++i) {
            const int ta = wave + 8 * i, g = ta >> 4, ti = ta & 15;
            const int d = g == 0 ? 1 : 4, tpr = 16 / d, res = ti / tpr, l0 = P0 / d + 32 * (ti % tpr);
            f32x16 o0, o1; float m_run, l_run;
            attn_tile(AQKV, b, hs, g, d, res, l0, vst, lane, o0, o1, m_run, l_run);
            const size_t row = (size_t)b * SEQ + (size_t)(l0 + r32) * d + res;
            const float inv = 1.0f / l_run;
            bf16* dst = (g == 0 ? YB : O2S) + row * 512 + hs * 64 + 4 * hi;
#pragma unroll
            for (int q = 0; q < 4; ++q) {
                v2u w0; w0.x = cvtpk(o0[4 * q] * inv, o0[4 * q + 1] * inv); w0.y = cvtpk(o0[4 * q + 2] * inv, o0[4 * q + 3] * inv);
                v2u w1; w1.x = cvtpk(o1[4 * q] * inv, o1[4 * q + 1] * inv); w1.y = cvtpk(o1[4 * q + 2] * inv, o1[4 * q + 3] * inv);
                *(v2u*)(dst + 8 * q) = w0; *(v2u*)(dst + 32 + 8 * q) = w1;
            }
            if (hi == 0) LSE[(size_t)g * (M * 8) + row * 8 + hs] = m_run + __log2f(l_run);
        }
        asm volatile("s_waitcnt vmcnt(0)" ::: "memory");
        __syncthreads();
#pragma unroll 1
        for (int i = 0; i < 2; ++i) {
            const int res = wave + 8 * i, l0 = P0 / 16;
            f32x16 o0, o1; float m_run, l_run;
            attn_tile(AQKV, b, hs, 2, 16, res, l0, vst, lane, o0, o1, m_run, l_run);
            const size_t row = (size_t)b * SEQ + (size_t)(l0 + r32) * 16 + res;
            const float e3 = m_run + __log2f(l_run);
            const float e1 = __uint_as_float(__hip_atomic_load((const unsigned*)(LSE + row * 8 + hs), RLX_AGENT));
            const float e2 = __uint_as_float(__hip_atomic_load((const unsigned*)(LSE + (size_t)(M * 8) + row * 8 + hs), RLX_AGENT));
            const float mx = fmaxf(fmaxf(e1, e2), e3);
            const float w1 = __builtin_amdgcn_exp2f(e1 - mx), w2 = __builtin_amdgcn_exp2f(e2 - mx), w3 = __builtin_amdgcn_exp2f(e3 - mx);
            const float iw = 1.0f / (w1 + w2 + w3);
            const float a1 = w1 * iw, a2 = w2 * iw, a3 = w3 * iw / l_run;
            const size_t off = row * 512 + hs * 64 + 4 * hi;
#pragma unroll
            for (int q = 0; q < 4; ++q) {
#pragma unroll
                for (int dh = 0; dh < 2; ++dh) {
                    const unsigned long long x1 = __hip_atomic_load((const unsigned long long*)(YB + off + 32 * dh + 8 * q), RLX_AGENT);
                    const unsigned long long x2 = __hip_atomic_load((const unsigned long long*)(O2S + off + 32 * dh + 8 * q), RLX_AGENT);
                    const unsigned x1l = (unsigned)x1, x1h = (unsigned)(x1 >> 32), x2l = (unsigned)x2, x2h = (unsigned)(x2 >> 32);
                    const float v0 = (dh ? o1[4 * q] : o0[4 * q]), v1 = (dh ? o1[4 * q + 1] : o0[4 * q + 1]), v2 = (dh ? o1[4 * q + 2] : o0[4 * q + 2]), v3 = (dh ? o1[4 * q + 3] : o0[4 * q + 3]);
                    const float y0 = a1 * __uint_as_float(x1l << 16) + a2 * __uint_as_float(x2l << 16) + a3 * v0;
                    const float y1 = a1 * __uint_as_float(x1l & 0xffff0000u) + a2 * __uint_as_float(x2l & 0xffff0000u) + a3 * v1;
                    const float y2 = a1 * __uint_as_float(x1h << 16) + a2 * __uint_as_float(x2h << 16) + a3 * v2;
                    const float y3 = a1 * __uint_as_float(x1h & 0xffff0000u) + a2 * __uint_as_float(x2h & 0xffff0000u) + a3 * v3;
                    v2u w; w.x = cvtpk(y0, y1); w.y = cvtpk(y2, y3);
                    *(v2u*)(YB + off + 32 * dh + 8 * q) = w;
                }
            }
        }
        asm volatile("s_waitcnt vmcnt(0)" ::: "memory");
        __syncthreads();
    }
}

namespace hg {
constexpr int IST = 272, PST = 144;
constexpr int OFF_QI = 0, OFF_KI = 64 * IST, OFF_KH = 2 * 64 * IST, OFF_VI = 3 * 64 * IST, OFF_PI = 4 * 64 * IST, OFF_PT = OFF_PI + 64 * PST, OFF_DEC = OFF_PT + 2048, OFF_RS = OFF_DEC + 512, OFF_END = OFF_RS + 2048;
static_assert(OFF_END <= RING_BYTES && OFF_PT % 16 == 0 && OFF_RS % 16 == 0, "hgrn LDS map");
typedef short v4i16_t __attribute__((ext_vector_type(4)));
typedef short s16x4 __attribute__((ext_vector_type(4)));
typedef unsigned v2u __attribute__((ext_vector_type(2)));
__device__ __forceinline__ s16x4 tr(const LAS unsigned char* p) { return __builtin_bit_cast(s16x4, __builtin_amdgcn_ds_read_tr16_b64_v4i16((LAS v4i16_t*)p)); }
__device__ __forceinline__ bf16x8 tr8(const LAS unsigned char* p, int second) { const s16x4 a = tr(p), b = tr(p + second); return (bf16x8){a[0], a[1], a[2], a[3], b[0], b[1], b[2], b[3]}; }
__device__ __forceinline__ unsigned cvtpk(float lo, float hi) { unsigned r; asm volatile("v_cvt_pk_bf16_f32 %0, %1, %2" : "=v"(r) : "v"(lo), "v"(hi)); return r; }

template <bool FULL> __device__ __forceinline__ void prep(const bf16* HQ, size_t row0, int h, float lbk, LAS unsigned char* L, int tid, float& dlog) {
    const int k = tid & 127, part = tid >> 7;
    LAS float* PT = (LAS float*)(L + OFF_PT);
    float cs[16], kk[16], qv[16];
#pragma unroll
    for (int i = 0; i < 16; ++i) {
        const size_t row = row0 + 16 * part + i;
        const float fp = bf2f(HQ[row * 2048 + 512 + h * 128 + k]);
        const float e = __expf(-fp), sg = 1.0f / (1.0f + e);
        const float f = lbk + (1.0f - lbk) * sg;
        kk[i] = (1.0f - lbk) * (e * sg);
        cs[i] = __logf(f);
        if (FULL) qv[i] = bf2f(HQ[row * 2048 + h * 128 + k]);
    }
#pragma unroll
    for (int i = 1; i < 16; ++i) cs[i] += cs[i - 1];
    PT[part * 128 + k] = cs[15];
    __syncthreads();
    const float p0 = PT[k], p1 = PT[128 + k], p2 = PT[256 + k], p3 = PT[384 + k];
    const float off = (part > 0 ? p0 : 0.f) + (part > 1 ? p1 : 0.f) + (part > 2 ? p2 : 0.f), tot = (p0 + p1) + (p2 + p3);
#pragma unroll
    for (int i = 0; i < 16; ++i) {
        const float Gt = off + cs[i]; const int t = 16 * part + i;
        if (FULL) {
            *(LAS bf16*)(L + OFF_QI + t * IST + k * 2) = (bf16)f2bf(qv[i] * __expf(Gt));
            *(LAS bf16*)(L + OFF_KI + t * IST + k * 2) = (bf16)f2bf(kk[i] * __expf(-Gt));
        }
        *(LAS bf16*)(L + OFF_KH + t * IST + k * 2) = (bf16)f2bf(kk[i] * __expf(tot - Gt));
    }
    if (part == 0) { ((LAS float*)(L + OFF_DEC))[k] = __expf(tot); dlog += tot; }
#pragma unroll
    for (int j = 0; j < 2; ++j) {
        const int c = tid + 512 * j, t = c >> 4, cc = c & 15;
        const v4u w = *(const v4u*)(HQ + (row0 + t) * 2048 + 1024 + h * 128 + cc * 8);
        *(LAS v4u*)(L + OFF_VI + t * IST + cc * 16) = w;
    }
    __syncthreads();
}
__device__ __forceinline__ void scores(LAS unsigned char* L, int wave, int lane) {
    const int fr = lane & 15, quad = lane >> 4;
#pragma unroll
    for (int e = 0; e < 2; ++e) {
        const int id = wave * 2 + e, ti = id >> 2, si = id & 3;
        f32x4 acc = (f32x4){0.f, 0.f, 0.f, 0.f};
        if (si <= ti) {
#pragma unroll
            for (int st = 0; st < 4; ++st) {
                const bf16x8 a = *(const LAS bf16x8*)(L + OFF_QI + (16 * ti + fr) * IST + (32 * st + 8 * quad) * 2);
                const bf16x8 b = *(const LAS bf16x8*)(L + OFF_KI + (16 * si + fr) * IST + (32 * st + 8 * quad) * 2);
                acc = __builtin_amdgcn_mfma_f32_16x16x32_bf16(a, b, acc, 0, 0, 0);
            }
        }
#pragma unroll
        for (int r = 0; r < 4; ++r) {
            const int t = 16 * ti + 4 * quad + r, s = 16 * si + fr;
            const float v = (s <= t) ? acc[r] : 0.f;
            *(LAS bf16*)(L + OFF_PI + t * PST + s * 2) = (bf16)f2bf(v);
        }
    }
}
template <bool FULL> __device__ __forceinline__ void mainstep(LAS unsigned char* L, int wave, int lane, f32x4 (&S)[8], f32x4 (&o)[4], bool update) {
    const int fr = lane & 15, quad = lane >> 4, q4 = fr >> 2, p = fr & 3;
    bf16x8 vf[2];
#pragma unroll
    for (int ss = 0; ss < 2; ++ss) vf[ss] = tr8(L + OFF_VI + (32 * ss + 8 * quad + q4) * IST + (16 * wave + 4 * p) * 2, 4 * IST);
    if (FULL) {
#pragma unroll
        for (int tt = 0; tt < 4; ++tt) {
            o[tt] = (f32x4){0.f, 0.f, 0.f, 0.f};
#pragma unroll
            for (int ss = 0; ss < 2; ++ss) {
                const bf16x8 a = *(const LAS bf16x8*)(L + OFF_PI + (16 * tt + fr) * PST + (32 * ss + 8 * quad) * 2);
                o[tt] = __builtin_amdgcn_mfma_f32_16x16x32_bf16(a, vf[ss], o[tt], 0, 0, 0);
            }
        }
#pragma unroll
        for (int ks = 0; ks < 4; ++ks) {
            v4u sw; sw.x = cvtpk(S[2 * ks][0], S[2 * ks][1]); sw.y = cvtpk(S[2 * ks][2], S[2 * ks][3]); sw.z = cvtpk(S[2 * ks + 1][0], S[2 * ks + 1][1]); sw.w = cvtpk(S[2 * ks + 1][2], S[2 * ks + 1][3]);
            const bf16x8 sf = __builtin_bit_cast(bf16x8, sw);
#pragma unroll
            for (int tt = 0; tt < 4; ++tt) {
                const LAS unsigned char* qa = L + OFF_QI + (16 * tt + fr) * IST + (32 * ks + 4 * quad) * 2;
                const v2u lo = *(const LAS v2u*)qa, hi = *(const LAS v2u*)(qa + 32);
                const v4u aw = (v4u){lo.x, lo.y, hi.x, hi.y};
                o[tt] = __builtin_amdgcn_mfma_f32_16x16x32_bf16(__builtin_bit_cast(bf16x8, aw), sf, o[tt], 0, 0, 0);
            }
        }
    }
    if (update) {
#pragma unroll
        for (int kt = 0; kt < 8; ++kt) {
            const f32x4 dc = *(const LAS f32x4*)(L + OFF_DEC + (16 * kt + 4 * quad) * 4);
            f32x4 c = S[kt] * dc;
#pragma unroll
            for (int ts = 0; ts < 2; ++ts) {
                const bf16x8 a = tr8(L + OFF_KH + (32 * ts + 8 * quad + q4) * IST + (16 * kt + 4 * p) * 2, 4 * IST);
                c = __builtin_amdgcn_mfma_f32_16x16x32_bf16(a, vf[ts], c, 0, 0, 0);
            }
            S[kt] = c;
        }
    }
}
__device__ __forceinline__ void pass1(const bf16* HQ, const float* lbraw, float* LST, float* DLG, LAS unsigned char* L, int vcu, int G, int tid, int wave, int lane) {
    const int fr = lane & 15, quad = lane >> 4;
    for (int u = vcu; u < 256; u += G) {
        const int b = u >> 5, h = (u >> 3) & 3, sc = u & 7;
        const int k = tid & 127;
        const float lbk = 1.0f / (1.0f + __expf(lbraw[512 + h * 128 + k] - lbraw[h * 128 + k]));
        f32x4 S[8], o[4];
#pragma unroll
        for (int kt = 0; kt < 8; ++kt) S[kt] = (f32x4){0.f, 0.f, 0.f, 0.f};
        float dlog = 0.f;
#pragma unroll 1
        for (int sub = 0; sub < 4; ++sub) {
            prep<false>(HQ, (size_t)b * SEQ + sc * 256 + sub * 64, h, lbk, L, tid, dlog);
            mainstep<false>(L, wave, lane, S, o, true);
        }
#pragma unroll
        for (int kt = 0; kt < 8; ++kt)
#pragma unroll
            for (int r = 0; r < 4; ++r) LST[((size_t)u * 128 + 16 * kt + 4 * quad + r) * 128 + 16 * wave + fr] = S[kt][r];
        if (tid < 128) DLG[u * 128 + tid] = dlog;
        __syncthreads();
    }
}
__device__ __forceinline__ void pass2(const bf16* HQ, const float* lbraw, const float* onorm, const float* LST, const float* DLG, bf16* YA, LAS unsigned char* L, int vcu, int G, int tid, int wave, int lane) {
    const int fr = lane & 15, quad = lane >> 4;
    LAS float* RS = (LAS float*)(L + OFF_RS);
    for (int u = vcu; u < 256; u += G) {
        const int b = u >> 5, h = (u >> 3) & 3, sc = u & 7;
        const int k = tid & 127;
        const float lbk = 1.0f / (1.0f + __expf(lbraw[512 + h * 128 + k] - lbraw[h * 128 + k]));
        const float gain = onorm[h * 128 + 16 * wave + fr];
        f32x4 S[8], o[4];
#pragma unroll
        for (int kt = 0; kt < 8; ++kt) S[kt] = (f32x4){0.f, 0.f, 0.f, 0.f};
#pragma unroll 1
        for (int j = 0; j < sc; ++j) {
            const int uj = (u & ~7) + j;
#pragma unroll
            for (int kt = 0; kt < 8; ++kt) {
                const f32x4 dl = *(const f32x4*)(DLG + uj * 128 + 16 * kt + 4 * quad);
#pragma unroll
                for (int r = 0; r < 4; ++r) S[kt][r] = __expf(dl[r]) * S[kt][r] + LST[((size_t)uj * 128 + 16 * kt + 4 * quad + r) * 128 + 16 * wave + fr];
            }
        }
        float dlog = 0.f;
#pragma unroll 1
        for (int sub = 0; sub < 4; ++sub) {
            const size_t row0 = (size_t)b * SEQ + sc * 256 + sub * 64;
            prep<true>(HQ, row0, h, lbk, L, tid, dlog);
            scores(L, wave, lane);
            __syncthreads();
            mainstep<true>(L, wave, lane, S, o, sub < 3);
#pragma unroll
            for (int tt = 0; tt < 4; ++tt)
#pragma unroll
                for (int r = 0; r < 4; ++r) {
                    float sq = o[tt][r] * o[tt][r];
                    sq += __shfl_xor(sq, 1); sq += __shfl_xor(sq, 2); sq += __shfl_xor(sq, 4); sq += __shfl_xor(sq, 8);
                    if (fr == 0) RS[(16 * tt + 4 * quad + r) * 8 + wave] = sq;
                }
            __syncthreads();
#pragma unroll
            for (int tt = 0; tt < 4; ++tt)
#pragma unroll
                for (int r = 0; r < 4; ++r) {
                    const int t = 16 * tt + 4 * quad + r;
                    const f32x4 r0 = *(const LAS f32x4*)(RS + t * 8), r1 = *(const LAS f32x4*)(RS + t * 8 + 4);
                    const float tot = ((r0[0] + r0[1]) + (r0[2] + r0[3])) + ((r1[0] + r1[1]) + (r1[2] + r1[3]));
                    const float rs = rsqrtf(tot * (1.0f / 128.0f) + EPS);
                    const size_t row = row0 + t;
                    const float og = bf2f(HQ[row * 2048 + 1536 + h * 128 + 16 * wave + fr]);
                    const float y = o[tt][r] * rs * gain * (og / (1.0f + __expf(-og)));
                    YA[row * 512 + h * 128 + 16 * wave + fr] = (bf16)f2bf(y);
                }
        }
        __syncthreads();
    }
}
}

struct Args { const float* in[15]; float* out; unsigned char* ws; int ph_lo, ph_hi, li, pad; };
__global__ void __launch_bounds__(NWAVES * 64, 2) mk_fwd(Args args) {
    __shared__ __attribute__((aligned(16))) unsigned char lds_raw[LDS_BYTES];
    LAS unsigned char* lds = (LAS unsigned char*)lds_raw;
    volatile LAS unsigned* MISC = (volatile LAS unsigned*)(lds + MISC_OFF);
    const int tid = threadIdx.x, lane = tid & 63, wave = __builtin_amdgcn_readfirstlane(tid >> 6);
    const int G = gridDim.x; const int bx = blockIdx.x; const int vcu = (G % 8 == 0) ? (bx % 8) * (G / 8) + bx / 8 : bx;
    const int gw = vcu * NWAVES + wave, NGW = G * NWAVES;
    unsigned char* ws = args.ws;
    gu32* ctl = (gu32*)(ws + WS_CTL);
    const float* x = args.in[0]; const float* ffn1_norm = args.in[1]; const float* ffn1_wgu = args.in[2]; const float* ffn1_wd = args.in[3]; const float* mix_norm = args.in[4];
    const float* w_in = args.in[5]; const float* hg_lb = args.in[6]; const float* hg_onorm = args.in[7]; const float* w_bhg = args.in[8]; const float* w_batt = args.in[9];
    const float* w_out = args.in[10]; const float* ffn2_norm = args.in[11]; const float* ffn2_wgu = args.in[12]; const float* ffn2_wd = args.in[13]; const float* final_norm = args.in[14];
    float* out = args.out;
    float* SS = (float*)(ws + WS_SS);
    bf16* WGU1 = (bf16*)(ws + WS_WGU1); bf16* WD1 = (bf16*)(ws + WS_WD1); bf16* WGU2 = (bf16*)(ws + WS_WGU2); bf16* WD2 = (bf16*)(ws + WS_WD2);
    bf16* WIN = (bf16*)(ws + WS_WIN); bf16* WA = (bf16*)(ws + WS_WA); bf16* WB = (bf16*)(ws + WS_WB); bf16* WO = (bf16*)(ws + WS_WO);
    bf16* HB = (bf16*)(ws + WS_HB); bf16* HID = (bf16*)(ws + WS_HID); bf16* AQKV = (bf16*)(ws + WS_AQKV); bf16* YB = (bf16*)(ws + WS_YB);
    bf16* HQ = (bf16*)(ws + WS_HQ); bf16* GATES = (bf16*)(ws + WS_GATES); bf16* YA = (bf16*)(ws + WS_YA); bf16* TMP = (bf16*)(ws + WS_TMP); bf16* MERGED = (bf16*)(ws + WS_MERGED);

    for (int u = tid; u < (LDS_BYTES - LDSCTL_OFF) / 4; u += NWAVES * 64) ((LAS unsigned*)(lds + LDSCTL_OFF))[u] = 0u;
    __syncthreads();
    XcdBarrier bar = xcd_barrier_post((unsigned*)(ctl + CW_BAR) + args.li * XCD_BAR_WORDS, MISC + 8);
    const int lo = args.ph_lo, hi = args.ph_hi;
#define IN(k) (lo <= (k) && (k) < hi)
#define SEAM(k) do { if (IN(k) && IN((k) + 1)) xcd_barrier(bar); } while (0)

    constexpr int I_GU = (D / 64) * (NGU / 32), I_DN = (FF / 64) * (D / 32), I_IN = (D / 64) * (NIN / 32), I_BR = (512 / 64) * (D / 32), I_WO = (D / 64) * (D / 32);
    if (IN(0)) {
        LAS float* scr = (LAS float*)(lds + RING_OFF + wave * 16384);
        for (int it = gw; it < I_GU + I_DN; it += NGW) {
            if (it < I_GU) p0_transpose_item(ffn1_wgu, ffn1_norm, D, NGU, WGU1, 1, scr, it, lane);
            else p0_transpose_item(ffn1_wd, nullptr, FF, D, WD1, 0, scr, it - I_GU, lane);
        }
        for (int m = gw; m < M; m += NGW) {
            const GAS f32x4* xr = (const GAS f32x4*)(x + (size_t)m * D) + lane;
            f32x4 v[4]; float s = 0.f;
#pragma unroll
            for (int j = 0; j < 4; ++j) { v[j] = xr[64 * j]; s += (v[j].x * v[j].x + v[j].y * v[j].y) + (v[j].z * v[j].z + v[j].w * v[j].w); }
            s = wave_sum(s);
            if (lane == 0) SS[m] = s;
            GAS unsigned long long* o8 = (GAS unsigned long long*)(HB + (size_t)m * D) + lane;
#pragma unroll
            for (int j = 0; j < 4; ++j) o8[64 * j] = (unsigned long long)pk2(v[j].x, v[j].y) | ((unsigned long long)pk2(v[j].z, v[j].w) << 32);
        }
        for (int i = vcu * (NWAVES * 64) + tid; i < 3 * M; i += G * NWAVES * 64) SS[M + i] = 0.f;
    }
    SEAM(0);
    if (IN(1)) {
        pg8::Gemm g{HB, WGU1, HB, WGU1, D}; pg8::StaticOrder S; S.init(M, NGU, G, bx);
        pg8::EpiSwiGLU E{HID, SS, FF};
        pg8::gemm_phase<pg8::EpiSwiGLU, pg8::StaticOrder, true, true>(lds + RING_OFF, g, S, E);
        const int nfull = ((M / 256) * (NGU / 256)) % G, nidle = nfull ? G - nfull : G, idx = nfull ? bx - nfull : bx;
        if (idx >= 0) {
            LAS float* scr = (LAS float*)(lds + RING_OFF + wave * 16384);
            for (int it = idx * NWAVES + wave; it < I_IN + 2 * I_BR + I_WO; it += nidle * NWAVES) {
                int r = it;
                if (r < I_IN) { p0_transpose_item(w_in, mix_norm, D, NIN, WIN, 2, scr, r, lane); continue; } r -= I_IN;
                if (r < I_BR) { p0_transpose_item(w_bhg, nullptr, 512, D, WA, 0, scr, r, lane); continue; } r -= I_BR;
                if (r < I_BR) { p0_transpose_item(w_batt, nullptr, 512, D, WB, 0, scr, r, lane); continue; } r -= I_BR;
                p0_transpose_item(w_out, nullptr, D, D, WO, 0, scr, r, lane);
            }
        }
    }
    SEAM(1);
    if (IN(2)) {
        pg8::Gemm g{HID, WD1, HID, WD1, FF}; pg8::StaticOrder S; S.init(M, D, G, bx);
        pg8::EpiResid<false, false> E{x, nullptr, nullptr, HB, SS + M, 0.5f};
        pg8::gemm_phase<pg8::EpiResid<false, false>, pg8::StaticOrder, true, true>(lds + RING_OFF, g, S, E);
    }
    SEAM(2);
    if (IN(3)) {
        pg8::Gemm g{HB, WIN + (size_t)4096 * D, HB, WIN + (size_t)4096 * D, D}; pg8::StaticOrder S; S.init(M, NATT, G, bx);
        pg8::EpiProj E{AQKV, NATT, AQKV, NATT, 1 << 30, SS + M};
        pg8::gemm_phase<pg8::EpiProj, pg8::StaticOrder, true, true>(lds + RING_OFF, g, S, E);
        const int nfull = ((M / 256) * (NATT / 256)) % G, nidle = nfull ? G - nfull : G, idx = nfull ? bx - nfull : bx;
        if (idx >= 0) {
            LAS float* scr = (LAS float*)(lds + RING_OFF + wave * 16384);
            for (int it = idx * NWAVES + wave; it < I_GU + I_DN; it += nidle * NWAVES) {
                if (it < I_GU) p0_transpose_item(ffn2_wgu, ffn2_norm, D, NGU, WGU2, 1, scr, it, lane);
                else p0_transpose_item(ffn2_wd, nullptr, FF, D, WD2, 0, scr, it - I_GU, lane);
            }
        }
    }
    SEAM(3);
    if (IN(4)) {
#if ATTN_NAIVE
        attn_naive(AQKV, YB, (LAS float*)(lds + RING_OFF) + wave * 64, gw, NGW, lane);
#else
        attn_phase(AQKV, YB, (bf16*)(ws + WS_O2S), (float*)(ws + WS_LSE), lds + RING_OFF, vcu, G, wave, lane);
#endif
    }
    SEAM(4);
    if (IN(5)) {
        pg8::Gemm g{HB, WIN, HB, WIN, D}; pg8::StaticOrder S; S.init(M, NHG + NGATE, G, bx);
        pg8::EpiProj E{HQ, NHG, GATES, NGATE, NHG / 256, SS + M};
        pg8::gemm_phase<pg8::EpiProj, pg8::StaticOrder, true, true>(lds + RING_OFF, g, S, E);
    }
    SEAM(5);
#if HGRN_NAIVE
    if (IN(6)) { hgrn_naive(HQ, hg_lb, hg_onorm, YA, lds + RING_OFF, tid); }
    SEAM(6);
    SEAM(7);
#else
    if (IN(6)) { hg::pass1(HQ, hg_lb, (float*)(ws + WS_LST), (float*)(ws + WS_DLG), lds + RING_OFF, vcu, G, tid, wave, lane); }
    SEAM(6);
    if (IN(7)) { hg::pass2(HQ, hg_lb, hg_onorm, (const float*)(ws + WS_LST), (const float*)(ws + WS_DLG), YA, lds + RING_OFF, vcu, G, tid, wave, lane); }
    SEAM(7);
#endif
    if (IN(8)) {
        pg8::Gemm g{YA, WA, YB, WB, 512}; pg8::MergeOrder S; S.init(M, D, G, bx);
        pg8::EpiMerge E{GATES, TMP, MERGED};
        pg8::gemm_phase<pg8::EpiMerge, pg8::MergeOrder, true, true>(lds + RING_OFF, g, S, E);
    }
    SEAM(8);
    if (IN(9)) {
        pg8::Gemm g{MERGED, WO, MERGED, WO, D}; pg8::StaticOrder S; S.init(M, D, G, bx);
        pg8::EpiResid<true, false> E{nullptr, HB, nullptr, HB, SS + 2 * M, 1.0f};
        pg8::gemm_phase<pg8::EpiResid<true, false>, pg8::StaticOrder, true, true>(lds + RING_OFF, g, S, E);
    }
    SEAM(9);
    if (IN(10)) {
        pg8::Gemm g{HB, WGU2, HB, WGU2, D}; pg8::StaticOrder S; S.init(M, NGU, G, bx);
        pg8::EpiSwiGLU E{HID, SS + 2 * M, FF};
        pg8::gemm_phase<pg8::EpiSwiGLU, pg8::StaticOrder, true, true>(lds + RING_OFF, g, S, E);
    }
    SEAM(10);
    if (IN(11)) {
        pg8::Gemm g{HID, WD2, HID, WD2, FF}; pg8::StaticOrder S; S.init(M, D, G, bx);
        pg8::EpiResid<true, true> E{nullptr, HB, out, nullptr, SS + 3 * M, 0.5f};
        pg8::gemm_phase<pg8::EpiResid<true, true>, pg8::StaticOrder, true, true>(lds + RING_OFF, g, S, E);
    }
    SEAM(11);
    if (IN(12)) {
        for (int m = gw; m < M; m += NGW) {
            GAS f32x4* r = (GAS f32x4*)(out + (size_t)m * D) + lane; const GAS f32x4* gn = (const GAS f32x4*)final_norm + lane;
            const float rs = rsqrtf(SS[3 * M + m] * (1.0f / D) + EPS);
#pragma unroll
            for (int j = 0; j < 4; ++j) { f32x4 v = r[64 * j]; v = v * rs * gn[64 * j]; r[64 * j] = v; }
        }
    }
#undef IN
#undef SEAM
}

extern "C" void kernel_launch(void* const* d_in, const int* in_sizes, int n_in, void* d_out, int out_size, void* d_ws, size_t ws_size, hipStream_t stream) {
    static int grid = 0;
    if (grid == 0) {
        if (n_in != 15 || out_size != M * D || ws_size < WS_END) { fprintf(stderr, "kernel_launch: unexpected shapes (n_in %d out %d ws %zu)\n", n_in, out_size, ws_size); grid = -1; return; }
        int dev = 0, cus = 0;
        if (hipGetDevice(&dev) != hipSuccess || hipDeviceGetAttribute(&cus, hipDeviceAttributeMultiprocessorCount, dev) != hipSuccess) { grid = -1; return; }
        grid = cus;
    }
    if (grid < 0) return;
    if (hipMemsetAsync((char*)d_ws + WS_CTL, 0, CTL_ZERO_BYTES, stream) != hipSuccess) return;
    Args a{};
    for (int i = 0; i < 15; ++i) a.in[i] = (const float*)d_in[i];
    a.out = (float*)d_out; a.ws = (unsigned char*)d_ws;
#if PROBE_REPEAT >= 0
    a.ph_lo = 0; a.ph_hi = PROBE_REPEAT + 1; a.li = 0; hipLaunchKernelGGL(mk_fwd, dim3(grid), dim3(NWAVES * 64), 0, stream, a);
    a.ph_lo = PROBE_REPEAT; a.ph_hi = N_PHASES; a.li = 1; hipLaunchKernelGGL(mk_fwd, dim3(grid), dim3(NWAVES * 64), 0, stream, a);
#else
    for (int li = 0; li < N_LAUNCHES; ++li) {
        a.ph_lo = (N_LAUNCHES == 1) ? 0 : li; a.ph_hi = (N_LAUNCHES == 1) ? N_PHASES : li + 1; a.li = li;
        hipLaunchKernelGGL(mk_fwd, dim3(grid), dim3(NWAVES * 64), 0, stream, a);
    }
#endif
}
```
